# Optimizing an MI355X kernel written in HIP

```python
import jax, jax.numpy as jnp
from jax import lax
import numpy as np

D_MODEL = 2048
BATCH = 2
SEQ = 4096
DEPTH = 1

MEM_LEN = 256
EPS = 1e-6
NEG_INF = -1e30
D_FF = 5632
MIX_WIDTH = D_MODEL
GLA_WIDTH = MIX_WIDTH // 2
MOBA_WIDTH = MIX_WIDTH - GLA_WIDTH
GLA_HEADS = 4
GLA_DV = GLA_WIDTH // GLA_HEADS
GLA_DK = GLA_DV // 2
GLA_QK = GLA_HEADS * GLA_DK
GLA_GATE_RANK = 16
GLA_GATE_TAU = 16.0
GLA_CHUNK = 64
MOBA_DH = 128
MOBA_HEADS = MOBA_WIDTH // MOBA_DH
MOBA_BLOCK = 256
MOBA_TOPK = 3
MOBA_QCHUNK = 32
XATTN_HEADS = 4
XATTN_DH = 128
XATTN_WIDTH = XATTN_HEADS * XATTN_DH
IN_SPLITS = (GLA_QK, GLA_QK, GLA_WIDTH, GLA_WIDTH, GLA_GATE_RANK, MOBA_WIDTH, MOBA_WIDTH, MOBA_WIDTH)
W_IN_COLS = sum(IN_SPLITS)

kernel_name = "hymba_gla_moba_macaron_layer"


def rms_norm(x, g):
    xf = x.astype(jnp.float32)
    y = xf * lax.rsqrt(jnp.mean(xf * xf, axis=-1, keepdims=True) + EPS)
    return (y * g.astype(jnp.float32)).astype(x.dtype)


def swiglu(h, w_gate, w_up, w_down):
    return (jax.nn.silu(h @ w_gate) * (h @ w_up)) @ w_down


def split_offsets(sizes):
    offs, acc = [], 0
    for s in sizes[:-1]:
        acc += s
        offs.append(acc)
    return offs


def gla_group(q, k, v, r, gate_lr, w_gate2, b_gate2, g_out):
    B, T, H, dk = q.shape
    dv = v.shape[-1]
    C = GLA_CHUNK
    N = T // C
    log_a = jax.nn.log_sigmoid((gate_lr @ w_gate2 + b_gate2).astype(jnp.float32)) / GLA_GATE_TAU
    log_a = log_a.reshape(B, T, H, dk)

    def chunks(a):
        return a.astype(jnp.float32).reshape(B, N, C, H, -1).transpose(0, 3, 1, 2, 4)

    qc = chunks(q) * (dk ** -0.5)
    kc, vc, ac = chunks(k), chunks(v), chunks(log_a)
    bcum = jnp.cumsum(ac, axis=3)
    b_last = bcum[:, :, :, -1:, :]
    q_dec = qc * jnp.exp(bcum)
    k_inv = kc * jnp.exp(-bcum)
    k_tail = kc * jnp.exp(b_last - bcum)
    causal = jnp.tril(jnp.ones((C, C), dtype=bool))
    att = jnp.where(causal, jnp.einsum('bhnid,bhnjd->bhnij', q_dec, k_inv), 0.0)
    o_intra = jnp.einsum('bhnij,bhnjv->bhniv', att, vc)
    upd = jnp.einsum('bhncd,bhncv->bhndv', k_tail, vc)
    decay = jnp.exp(b_last[:, :, :, 0, :])

    def step(S, inp):
        u, dcy = inp
        return dcy[..., None] * S + u, S

    S0 = jnp.zeros((B, H, dk, dv), jnp.float32)
    _, S_prev = lax.scan(step, S0, (jnp.moveaxis(upd, 2, 0), jnp.moveaxis(decay, 2, 0)))
    S_prev = jnp.moveaxis(S_prev, 0, 2)
    o_inter = jnp.einsum('bhncd,bhndv->bhncv', q_dec, S_prev)
    o = (o_intra + o_inter).transpose(0, 2, 3, 1, 4).reshape(B, T, H, dv)
    o = rms_norm(o, g_out) * jax.nn.silu(r.astype(jnp.float32))
    return o.reshape(B, T, H * dv).astype(q.dtype)


def moba_group(q, k, v, g_q, g_k):
    B, T, H, dh = q.shape
    BS, QC = MOBA_BLOCK, MOBA_QCHUNK
    NB = -(-T // BS)
    Tp = NB * BS
    n_sel = min(MOBA_TOPK, NB)
    scale = dh ** -0.5
    qh = rms_norm(q, g_q).transpose(0, 2, 1, 3)
    kh = rms_norm(k, g_k).transpose(0, 2, 1, 3)
    vh = v.transpose(0, 2, 1, 3)
    pad = ((0, 0), (0, 0), (0, Tp - T), (0, 0))
    kb = jnp.pad(kh, pad).reshape(B, H, NB, BS, dh)
    vb = jnp.pad(vh, pad).reshape(B, H, NB, BS, dh)
    k_mean = jnp.mean(kb, axis=3)
    qblk = jnp.arange(T) // BS
    gate = jnp.einsum('bhtd,bhnd->bhtn', qh, k_mean).astype(jnp.float32)
    past = jnp.arange(NB)[None, :] < qblk[:, None]
    gate = jnp.where(past, gate, NEG_INF)
    _, idx = lax.top_k(gate, n_sel)
    valid = idx < qblk[None, None, :, None]

    NQ = T // QC

    def qchunks(a):
        return jnp.moveaxis(a.reshape((B, H, NQ, QC) + a.shape[3:]), 2, 0)

    bi = jnp.arange(B)[:, None, None, None]
    hi = jnp.arange(H)[None, :, None, None]

    def one_chunk(args):
        q_c, idx_c, valid_c, c = args
        k_g = kb[bi, hi, idx_c]
        v_g = vb[bi, hi, idx_c]
        s_past = jnp.einsum('bhqd,bhqjkd->bhqjk', q_c, k_g).astype(jnp.float32) * scale
        s_past = jnp.where(valid_c[..., None], s_past, NEG_INF).reshape(B, H, QC, n_sel * BS)
        blk = (c * QC) // BS
        k_own = lax.dynamic_index_in_dim(kb, blk, axis=2, keepdims=False)
        v_own = lax.dynamic_index_in_dim(vb, blk, axis=2, keepdims=False)
        q_pos = c * QC + jnp.arange(QC)
        k_pos = blk * BS + jnp.arange(BS)
        s_own = jnp.einsum('bhqd,bhkd->bhqk', q_c, k_own).astype(jnp.float32) * scale
        s_own = jnp.where(k_pos[None, :] <= q_pos[:, None], s_own, NEG_INF)
        p = jax.nn.softmax(jnp.concatenate([s_past, s_own], axis=-1), axis=-1).astype(v_g.dtype)
        p_past = p[..., :n_sel * BS].reshape(B, H, QC, n_sel, BS)
        return (jnp.einsum('bhqjk,bhqjkd->bhqd', p_past, v_g)
                + jnp.einsum('bhqk,bhkd->bhqd', p[..., n_sel * BS:], v_own))

    out = lax.map(one_chunk, (qchunks(qh), qchunks(idx), qchunks(valid), jnp.arange(NQ)))
    out = jnp.moveaxis(out, 0, 2).reshape(B, H, T, dh)
    return out.transpose(0, 2, 1, 3).reshape(B, T, H * dh)


def memory_cross_attn(h, mem_n, w_q, w_kv, w_o, g_q, g_k):
    B, T, _ = h.shape
    M = mem_n.shape[1]
    q = rms_norm((h @ w_q).reshape(B, T, XATTN_HEADS, XATTN_DH), g_q)
    kv = (mem_n @ w_kv).reshape(B, M, 2, XATTN_HEADS, XATTN_DH)
    k = rms_norm(kv[:, :, 0], g_k)
    v = kv[:, :, 1]
    s = jnp.einsum('bthd,bmhd->bhtm', q, k).astype(jnp.float32) * (XATTN_DH ** -0.5)
    p = jax.nn.softmax(s, axis=-1).astype(v.dtype)
    o = jnp.einsum('bhtm,bmhd->bthd', p, v).reshape(B, T, XATTN_WIDTH)
    return o @ w_o


def setup_inputs(seed: int = 0) -> dict:
    key = jax.random.key(seed)
    ks = jax.random.split(key, 32)
    L = DEPTH

    def w(k, shape, fan_in):
        return jax.random.normal(k, shape, jnp.float32) * (fan_in ** -0.5)

    def gain(k, shape):
        return 1.0 + 0.05 * jax.random.normal(k, shape, jnp.float32)

    return {
        "x": jax.random.normal(ks[0], (BATCH, SEQ, D_MODEL), jnp.float32),
        "mem": jax.random.normal(ks[1], (BATCH, MEM_LEN, D_MODEL), jnp.float32),
        "ffn1_norm": gain(ks[2], (L, D_MODEL)),
        "ffn1_w_gate": w(ks[3], (L, D_MODEL, D_FF), D_MODEL),
        "ffn1_w_up": w(ks[4], (L, D_MODEL, D_FF), D_MODEL),
        "ffn1_w_down": w(ks[5], (L, D_FF, D_MODEL), D_FF),
        "mix_norm": gain(ks[6], (L, D_MODEL)),
        "w_in": w(ks[7], (L, D_MODEL, W_IN_COLS), D_MODEL),
        "gla_w_gate2": w(ks[8], (L, GLA_GATE_RANK, GLA_QK), GLA_GATE_RANK),
        "gla_b_gate2": 0.1 * jax.random.normal(ks[9], (L, GLA_QK), jnp.float32),
        "gla_out_norm": gain(ks[10], (L, GLA_DV)),
        "moba_q_norm": gain(ks[11], (L, MOBA_DH)),
        "moba_k_norm": gain(ks[12], (L, MOBA_DH)),
        "w_out": w(ks[13], (L, MIX_WIDTH, D_MODEL), MIX_WIDTH),
        "xattn_norm": gain(ks[14], (L, D_MODEL)),
        "mem_norm": gain(ks[15], (L, D_MODEL)),
        "xattn_w_q": w(ks[16], (L, D_MODEL, XATTN_WIDTH), D_MODEL),
        "xattn_w_kv": w(ks[17], (L, D_MODEL, 2 * XATTN_WIDTH), D_MODEL),
        "xattn_w_o": w(ks[18], (L, XATTN_WIDTH, D_MODEL), XATTN_WIDTH),
        "xattn_q_norm": gain(ks[19], (L, XATTN_DH)),
        "xattn_k_norm": gain(ks[20], (L, XATTN_DH)),
        "ffn2_norm": gain(ks[21], (L, D_MODEL)),
        "ffn2_w_gate": w(ks[22], (L, D_MODEL, D_FF), D_MODEL),
        "ffn2_w_up": w(ks[23], (L, D_MODEL, D_FF), D_MODEL),
        "ffn2_w_down": w(ks[24], (L, D_FF, D_MODEL), D_FF),
    }


def reference(x, mem, ffn1_norm, ffn1_w_gate, ffn1_w_up, ffn1_w_down, mix_norm, w_in,
              gla_w_gate2, gla_b_gate2, gla_out_norm, moba_q_norm, moba_k_norm, w_out,
              xattn_norm, mem_norm, xattn_w_q, xattn_w_kv, xattn_w_o, xattn_q_norm,
              xattn_k_norm, ffn2_norm, ffn2_w_gate, ffn2_w_up, ffn2_w_down):
    B, T, _ = x.shape
    offs = split_offsets(IN_SPLITS)
    for l in range(DEPTH):
        x = x + 0.5 * swiglu(rms_norm(x, ffn1_norm[l]), ffn1_w_gate[l], ffn1_w_up[l], ffn1_w_down[l])
        h = rms_norm(x, mix_norm[l])
        u = h @ w_in[l]
        g_q, g_k, g_v, g_r, g_lr, m_q, m_k, m_v = jnp.split(u, offs, axis=-1)
        o_gla = gla_group(g_q.reshape(B, T, GLA_HEADS, GLA_DK), g_k.reshape(B, T, GLA_HEADS, GLA_DK),
                          g_v.reshape(B, T, GLA_HEADS, GLA_DV), g_r.reshape(B, T, GLA_HEADS, GLA_DV),
                          g_lr, gla_w_gate2[l], gla_b_gate2[l], gla_out_norm[l])
        o_moba = moba_group(m_q.reshape(B, T, MOBA_HEADS, MOBA_DH), m_k.reshape(B, T, MOBA_HEADS, MOBA_DH),
                            m_v.reshape(B, T, MOBA_HEADS, MOBA_DH), moba_q_norm[l], moba_k_norm[l])
        x = x + jnp.concatenate([o_gla, o_moba], axis=-1) @ w_out[l]
        x = x + memory_cross_attn(rms_norm(x, xattn_norm[l]), rms_norm(mem, mem_norm[l]),
                                  xattn_w_q[l], xattn_w_kv[l], xattn_w_o[l],
                                  xattn_q_norm[l], xattn_k_norm[l])
        x = x + 0.5 * swiglu(rms_norm(x, ffn2_norm[l]), ffn2_w_gate[l], ffn2_w_up[l], ffn2_w_down[l])
    return x
```

```cpp
#include <hip/hip_runtime.h>
#include <hip/hip_cooperative_groups.h>
#include <cstdio>
#include <cstdint>
namespace cg = cooperative_groups;
namespace pg8 {
#define PG8_LAS __attribute__((address_space(3)))
typedef unsigned short bf16_t;
typedef short bf16x8 __attribute__((ext_vector_type(8)));
typedef float f32x4 __attribute__((ext_vector_type(4)));
typedef unsigned u32x4 __attribute__((ext_vector_type(4)));
constexpr int BM = 256, BK = 64, HALF = 128, HTB = HALF * BK * 2  , STAGE_BYTES = 8 * HTB, NXCD = 8, WGM = 8;

__host__ __device__ __forceinline__ int lds_byte(int r, int c) { const int st = (r >> 4) * 2 + (c >> 5), rr = r & 15, cc = c & 31, ob = rr * 64 + cc * 2; return st * 1024 + (ob ^ (((ob >> 9) & 1) << 5)); }
__host__ __device__ __forceinline__ void stage_rc(int b, int& R, int& C) { const int st = b / 1024, sb = b % 1024, swz = sb ^ (((sb >> 9) & 1) << 5); R = (st >> 1) * 16 + swz / 64; C = (st & 1) * 32 + (swz % 64) / 2; }
__host__ __device__ __forceinline__ int perm32(int rho) { const int n = rho >> 4, i = rho & 15; return 8 * (i >> 2) + 4 * n + (i & 3); }

struct Unit { int pm, pn; };
struct Gemm { const bf16_t* A; const bf16_t* Bt; int M, N, K; };

struct StaticOrder {
    int nM, nN, nwg, G, c;
    __host__ __device__ void init(int M, int N, int G_, int c_) { nM = M / BM; nN = N / BM; nwg = nM * nN; G = G_; c = c_; }
    __host__ __device__ bool next(int i, Unit& u) const {
        const long L = (long)i * G + c; if (L >= nwg) return false;
        int wgid = (int)L; { const int q = nwg / NXCD, r = nwg % NXCD, xcd = wgid % NXCD, off = wgid / NXCD; wgid = (xcd < r ? xcd * (q + 1) : r * (q + 1) + (xcd - r) * q) + off; }
        const int nig = WGM * nN, gid = wgid / nig, fm = gid * WGM, gsz = (nM - fm) < WGM ? (nM - fm) : WGM;
        u.pm = fm + ((wgid % nig) % gsz); u.pn = (wgid % nig) / gsz; return true;
    }
    __device__ __forceinline__ void a_ready(const Unit&) const {}
    __device__ __forceinline__ void done(const Unit&) const {}
};


__device__ __forceinline__ unsigned cvt_pk_bf16(float lo, float hi) { unsigned r; asm volatile("v_cvt_pk_bf16_f32 %0, %1, %2" : "=v"(r) : "v"(lo), "v"(hi)); return r; }
typedef unsigned u32x2 __attribute__((ext_vector_type(2)));

__device__ __forceinline__ float row_rs(const float* SS, int row, int fq) {
    const f32x4* p = (const f32x4*)(SS + (size_t)row * 32 + fq * 8);
    const f32x4 a = p[0], b = p[1];
    float s = ((a[0] + a[1]) + (a[2] + a[3])) + ((b[0] + b[1]) + (b[2] + b[3]));
    s += __shfl_xor(s, 16); s += __shfl_xor(s, 32);
    return rsqrtf(s * (1.0f / 2048.0f) + 1e-6f);
}
__device__ __forceinline__ float silu_f(float g) { return g * __builtin_amdgcn_rcpf(1.0f + __expf(-g)); }

struct EpiSwiGLU {
    static constexpr bool PERM = true, AFTER_DRAIN = false;
    bf16_t* O; int ldc; const float* SS;
    __device__ __forceinline__ void operator()(const f32x4 (&acc)[2][2][4][2], const Unit& u, int wr, int wc, int fr, int fq) const {
        const int row0 = u.pm * BM + wr * 64 + fr, col0 = u.pn * HALF + wc * 32 + 8 * fq;
#pragma unroll
        for (int ai = 0; ai < 2; ++ai)
#pragma unroll
            for (int m = 0; m < 4; ++m) {
                const int row = row0 + ai * HALF + m * 16;
                const float rs = row_rs(SS, row, fq);
                float v[8];
#pragma unroll
                for (int n = 0; n < 2; ++n)
#pragma unroll
                    for (int j = 0; j < 4; ++j) { const float g = acc[ai][0][m][n][j] * rs, up = acc[ai][1][m][n][j] * rs; v[n * 4 + j] = silu_f(g) * up; }
                u32x4 w; w.x = cvt_pk_bf16(v[0], v[1]); w.y = cvt_pk_bf16(v[2], v[3]); w.z = cvt_pk_bf16(v[4], v[5]); w.w = cvt_pk_bf16(v[6], v[7]);
                *(u32x4*)(O + (size_t)row * ldc + col0) = w;
            }
    }
};

struct EpiResid {
    static constexpr bool PERM = false, AFTER_DRAIN = false;
    const float* base; float* out; int ldc; float alpha; bf16_t* XN; const float* gain; float* SS;
    __device__ __forceinline__ void operator()(const f32x4 (&acc)[2][2][4][2], const Unit& u, int wr, int wc, int fr, int fq) const {
        const int row0 = u.pm * BM + wr * 64 + fr, col0 = u.pn * BM + wc * 32 + 4 * fq;
#pragma unroll
        for (int ai = 0; ai < 2; ++ai)
#pragma unroll
            for (int m = 0; m < 4; ++m) {
                const int row = row0 + ai * HALF + m * 16; const size_t off = (size_t)row * ldc + col0; float ssq = 0.f;
#pragma unroll
                for (int bj = 0; bj < 2; ++bj)
#pragma unroll
                    for (int n = 0; n < 2; ++n) { const int c = bj * HALF + n * 16;
                        const f32x4 b = *(const f32x4*)(base + off + c); const f32x4 o = b + acc[ai][bj][m][n] * alpha;
                        *(f32x4*)(out + off + c) = o;
                        if (XN) { const f32x4 gv = *(const f32x4*)(gain + col0 + c); const f32x4 w = o * gv;
                            u32x2 pk; pk.x = cvt_pk_bf16(w[0], w[1]); pk.y = cvt_pk_bf16(w[2], w[3]); *(u32x2*)(XN + off + c) = pk;
                            ssq += (o[0] * o[0] + o[1] * o[1]) + (o[2] * o[2] + o[3] * o[3]); } }
                if (SS) { ssq += __shfl_xor(ssq, 16); ssq += __shfl_xor(ssq, 32); if (fq == 0) SS[(size_t)row * 32 + u.pn * 4 + wc] = ssq; }
                asm volatile("" ::: "memory");
            }
    }
};

template <bool LRX> struct EpiScale {
    static constexpr bool PERM = true, AFTER_DRAIN = false;
    bf16_t* O; int ldc; const float* SS; float* LR;
    __device__ __forceinline__ void operator()(const f32x4 (&acc)[2][2][4][2], const Unit& u, int wr, int wc, int fr, int fq) const {
        const int row0 = u.pm * BM + wr * 64 + fr, col0 = u.pn * BM + wc * 32 + 8 * fq;
#pragma unroll
        for (int ai = 0; ai < 2; ++ai)
#pragma unroll
            for (int m = 0; m < 4; ++m) {
                const int row = row0 + ai * HALF + m * 16;
                const float rs = SS ? row_rs(SS, row, fq) : 1.0f;
#pragma unroll
                for (int bj = 0; bj < 2; ++bj) { const f32x4 v0 = acc[ai][bj][m][0] * rs, v1 = acc[ai][bj][m][1] * rs;
                    u32x4 w; w.x = cvt_pk_bf16(v0[0], v0[1]); w.y = cvt_pk_bf16(v0[2], v0[3]); w.z = cvt_pk_bf16(v1[0], v1[1]); w.w = cvt_pk_bf16(v1[2], v1[3]);
                    *(u32x4*)(O + (size_t)row * ldc + col0 + bj * HALF) = w;
                    if (LRX) { if (u.pn == 12 && bj == 0 && wc == 0 && fq < 2) { *(f32x4*)(LR + (size_t)row * 16 + 8 * fq) = v0; *(f32x4*)(LR + (size_t)row * 16 + 8 * fq + 4) = v1; } } }
            }
    }
};
template <class Epi, class Sched, bool ALIGN_EPI = false, bool SP2 = false>
__device__ __forceinline__ void gemm_phase(PG8_LAS unsigned char* lds, const Gemm g, const Sched& S, const Epi& E) {
    const int tid = threadIdx.x, wid = __builtin_amdgcn_readfirstlane(tid >> 6), lane = tid & 63, wr = wid >> 2, wc = wid & 3, fr = lane & 15, fq = lane >> 4;
    const int K = g.K, nt = K / BK;
    unsigned voffA[2], voffB[2];
#pragma unroll
    for (int i = 0; i < 2; ++i) { int R, C; stage_rc(tid * 16 + i * 8192, R, C); const int Rb = Epi::PERM ? ((R & ~31) + perm32(R & 31)) : R;
        voffA[i] = (unsigned)(R * K + C) * 2u; voffB[i] = (unsigned)(Rb * K + C) * 2u; }
    const size_t kstep = (size_t)(BK * 2);
    const size_t hstep = (size_t)HALF * K * 2;
    const size_t tstep = 2 * hstep;
    const unsigned ldsw = (unsigned)wid * 1024u;
    const int aoff = lds_byte(wr * 64 + fr, fq * 8), boff = lds_byte(wc * 32 + fr, fq * 8);
#define PG8_SA(b, h) (((b) * 2 + (h)) * HTB)
#define PG8_SB(b, h) ((4 + (b) * 2 + (h)) * HTB)
#define PG8_STAGE(bufoff, gbase, voff) do { _Pragma("unroll") for (int _i = 0; _i < 2; ++_i) \
        __builtin_amdgcn_global_load_lds((const unsigned*)((const char*)(gbase) + (voff)[_i]), (PG8_LAS unsigned*)(lds + (bufoff) + ldsw + _i * 8192), 16, 0, 0); } while (0)
#define PG8_LDA(dst, b, h) do { _Pragma("unroll") for (int m = 0; m < 4; ++m) _Pragma("unroll") for (int k = 0; k < 2; ++k) dst[m][k] = *(const PG8_LAS bf16x8*)(lds + PG8_SA(b, h) + aoff + m * 2048 + k * 1024); } while (0)
#define PG8_LDB(dst, b, h) do { _Pragma("unroll") for (int n = 0; n < 2; ++n) _Pragma("unroll") for (int k = 0; k < 2; ++k) dst[n][k] = *(const PG8_LAS bf16x8*)(lds + PG8_SB(b, h) + boff + n * 2048 + k * 1024); } while (0)
#define PG8_MMA(ai, bj, At, Bt) do { __builtin_amdgcn_s_setprio(1); _Pragma("unroll") for (int m = 0; m < 4; ++m) _Pragma("unroll") for (int n = 0; n < 2; ++n) _Pragma("unroll") for (int k = 0; k < 2; ++k) \
        acc[ai][bj][m][n] = __builtin_amdgcn_mfma_f32_16x16x32_bf16(Bt[n][k], At[m][k], acc[ai][bj][m][n], 0, 0, 0); __builtin_amdgcn_s_setprio(0); } while (0)
#define PG8_WAIT_V(n) asm volatile("s_waitcnt vmcnt(" #n ")" ::: "memory")
#define PG8_WAIT_L(n) asm volatile("s_waitcnt lgkmcnt(" #n ")" ::: "memory")
#define PG8_BAR __builtin_amdgcn_s_barrier()
#define PG8_SCHED __builtin_amdgcn_sched_barrier(0)
    Unit cur, nxt; int ui = 0;
    if (!S.next(0, cur)) return;
    f32x4 acc[2][2][4][2];
#pragma unroll
    for (int a = 0; a < 2; ++a)
#pragma unroll
        for (int b = 0; b < 2; ++b)
#pragma unroll
            for (int m = 0; m < 4; ++m)
#pragma unroll
                for (int n = 0; n < 2; ++n) acc[a][b][m][n] = (f32x4){0.f, 0.f, 0.f, 0.f};
    bf16x8 At[4][2], B0[2][2], B1[2][2];
    const char* cA = (const char*)g.A + (size_t)cur.pm * tstep; const char* cB = (const char*)g.Bt + (size_t)cur.pn * tstep;
    S.a_ready(cur);
    if constexpr (SP2) {
        PG8_STAGE(PG8_SB(0, 0), cB, voffB); PG8_STAGE(PG8_SB(0, 1), cB + hstep, voffB); PG8_STAGE(PG8_SA(0, 0), cA, voffA); PG8_STAGE(PG8_SA(0, 1), cA + hstep, voffA);
        if (wr == 1) PG8_BAR;
        PG8_WAIT_V(2); PG8_BAR;
        PG8_STAGE(PG8_SB(1, 0), cB + kstep, voffB); PG8_STAGE(PG8_SA(1, 0), cA + kstep, voffA); PG8_STAGE(PG8_SB(1, 1), cB + hstep + kstep, voffB);
        PG8_WAIT_V(6); PG8_BAR;
    } else {
        PG8_STAGE(PG8_SB(0, 0), cB, voffB); PG8_STAGE(PG8_SA(0, 0), cA, voffA); PG8_STAGE(PG8_SB(0, 1), cB + hstep, voffB); PG8_STAGE(PG8_SA(0, 1), cA + hstep, voffA);
        if (wr == 1) PG8_BAR;
        PG8_WAIT_V(4); PG8_BAR;
        PG8_STAGE(PG8_SB(1, 0), cB + kstep, voffB); PG8_STAGE(PG8_SA(1, 0), cA + kstep, voffA); PG8_STAGE(PG8_SB(1, 1), cB + hstep + kstep, voffB);
        PG8_WAIT_V(6); PG8_BAR;
    }
    for (;;) {
        const bool has_next = S.next(ui + 1, nxt);
        const char* nA = has_next ? (const char*)g.A + (size_t)nxt.pm * tstep : cA; const char* nB = has_next ? (const char*)g.Bt + (size_t)nxt.pn * tstep : cB;
        for (int t = 0; t < nt; t += 2) {
            const bool last = (t == nt - 2);
            const char* a1 = cA + (size_t)(t + 1) * kstep;
            const char* a2 = last ? nA : cA + (size_t)(t + 2) * kstep; const char* b2 = last ? nB : cB + (size_t)(t + 2) * kstep;
            const char* a3 = a2 + kstep; const char* b3 = b2 + kstep;
            if (last && has_next) S.a_ready(nxt);
            if constexpr (SP2) {
            PG8_LDB(B0, 0, 0); PG8_LDB(B1, 0, 1); PG8_SCHED; PG8_LDA(At, 0, 0); PG8_STAGE(PG8_SA(1, 1), a1 + hstep, voffA);
            PG8_WAIT_V(8); PG8_WAIT_L(0); PG8_BAR; PG8_MMA(0, 0, At, B0); PG8_MMA(0, 1, At, B1); PG8_BAR; PG8_SCHED;
            PG8_LDA(At, 0, 1); PG8_STAGE(PG8_SB(0, 0), b2, voffB); PG8_STAGE(PG8_SB(0, 1), b2 + hstep, voffB); PG8_STAGE(PG8_SA(0, 0), a2, voffA);
            PG8_WAIT_V(8); PG8_WAIT_L(0); PG8_BAR; PG8_MMA(1, 0, At, B0); PG8_MMA(1, 1, At, B1); PG8_BAR; PG8_SCHED;
            PG8_LDB(B0, 1, 0); PG8_LDB(B1, 1, 1); PG8_SCHED; PG8_LDA(At, 1, 0); PG8_STAGE(PG8_SA(0, 1), a2 + hstep, voffA);
            PG8_WAIT_V(8); PG8_WAIT_L(0); PG8_BAR; PG8_MMA(0, 0, At, B0); PG8_MMA(0, 1, At, B1); PG8_BAR; PG8_SCHED;
            PG8_LDA(At, 1, 1); PG8_STAGE(PG8_SB(1, 0), b3, voffB); PG8_STAGE(PG8_SB(1, 1), b3 + hstep, voffB); PG8_STAGE(PG8_SA(1, 0), a3, voffA);
            PG8_WAIT_V(8); PG8_WAIT_L(0); PG8_BAR; PG8_MMA(1, 0, At, B0); PG8_MMA(1, 1, At, B1); PG8_BAR; PG8_SCHED;
            } else {
            PG8_LDB(B0, 0, 0); PG8_SCHED; PG8_LDA(At, 0, 0); PG8_STAGE(PG8_SA(1, 1), a1 + hstep, voffA);
            PG8_WAIT_L(8); PG8_BAR; PG8_WAIT_L(0); PG8_MMA(0, 0, At, B0); PG8_BAR; PG8_SCHED;
            PG8_LDB(B1, 0, 1); PG8_STAGE(PG8_SB(0, 0), b2, voffB);
            PG8_BAR; PG8_WAIT_L(0); PG8_MMA(0, 1, At, B1); PG8_BAR;
            PG8_LDA(At, 0, 1); PG8_STAGE(PG8_SA(0, 0), a2, voffA);
            PG8_BAR; PG8_WAIT_L(0); PG8_MMA(1, 0, At, B0); PG8_BAR; PG8_SCHED;
            PG8_STAGE(PG8_SB(0, 1), b2 + hstep, voffB);
            PG8_WAIT_V(6); PG8_BAR; PG8_MMA(1, 1, At, B1); PG8_BAR;
            PG8_LDB(B0, 1, 0); PG8_SCHED; PG8_LDA(At, 1, 0); PG8_STAGE(PG8_SA(0, 1), a2 + hstep, voffA);
            PG8_WAIT_L(8); PG8_BAR; PG8_WAIT_L(0); PG8_MMA(0, 0, At, B0); PG8_BAR; PG8_SCHED;
            PG8_LDB(B1, 1, 1); PG8_STAGE(PG8_SB(1, 0), b3, voffB);
            PG8_BAR; PG8_WAIT_L(0); PG8_MMA(0, 1, At, B1); PG8_BAR;
            PG8_LDA(At, 1, 1); PG8_STAGE(PG8_SA(1, 0), a3, voffA);
            PG8_BAR; PG8_WAIT_L(0); PG8_MMA(1, 0, At, B0); PG8_BAR; PG8_SCHED;
            PG8_STAGE(PG8_SB(1, 1), b3 + hstep, voffB);
            PG8_WAIT_V(6); PG8_BAR; PG8_MMA(1, 1, At, B1); PG8_BAR;
            }
        }
        if constexpr (ALIGN_EPI) { if (wr == 0) PG8_BAR; }
        if constexpr (!Epi::AFTER_DRAIN) { E(acc, cur, wr, wc, fr, fq); S.done(cur); }
        if (!has_next) break;
#pragma unroll
        for (int a = 0; a < 2; ++a)
#pragma unroll
            for (int b = 0; b < 2; ++b)
#pragma unroll
                for (int m = 0; m < 4; ++m)
#pragma unroll
                    for (int n = 0; n < 2; ++n) acc[a][b][m][n] = (f32x4){0.f, 0.f, 0.f, 0.f};
        cur = nxt; cA = nA; cB = nB; ++ui;
        if constexpr (ALIGN_EPI) { if (wr == 1) PG8_BAR; }
    }
    PG8_WAIT_V(0);
    if constexpr (!ALIGN_EPI) { if (wr == 0) PG8_BAR; }
    PG8_BAR;
    if constexpr (Epi::AFTER_DRAIN) { E.fused(acc, cur, wr, wc, fr, fq, lds, wid, lane); S.done(cur); }
#undef PG8_SA
#undef PG8_SB
#undef PG8_STAGE
#undef PG8_LDA
#undef PG8_LDB
#undef PG8_MMA
#undef PG8_WAIT_V
#undef PG8_WAIT_L
#undef PG8_BAR
#undef PG8_SCHED
}
}

constexpr int NWAVES = 8, NTHR = 512;
constexpr int B_ = 2, T_ = 4096, D_ = 2048, M_ = B_ * T_, FF_ = 5632, NGU = 2 * FF_, MEML = 256, MM_ = B_ * MEML;
constexpr int NIN = 6160, NINP = 6400;
constexpr int GQ_OFF = 0, GK_OFF = 512, GV_OFF = 1024, GR_OFF = 2048, MQ_OFF = 3072, MK_OFF = 4096, MV_OFF = 5120, NU = 6144;
constexpr float EPS = 1e-6f;
#ifndef MK_MULTI
#define MK_MULTI 0
#endif
#ifndef ANCHOR_GLA
#define ANCHOR_GLA 0
#endif
#ifndef ANCHOR_MOBA
#define ANCHOR_MOBA 0
#endif
#ifndef ANCHOR_XATTN
#define ANCHOR_XATTN 0
#endif
constexpr int NPH = 13;

constexpr size_t MiB = 1u << 20;
constexpr size_t WS_W1GU = 1 * MiB, WS_W1D = 45 * MiB, WS_W2GU = 67 * MiB, WS_W2D = 111 * MiB, WS_WIN = 133 * MiB, WS_WOUT = 158 * MiB,
                 WS_WQ = 166 * MiB, WS_WKV = 168 * MiB, WS_WO = 172 * MiB;
constexpr size_t WS_XN = 174 * MiB, WS_MEMN = 206 * MiB, WS_SS = 208 * MiB;
constexpr size_t WS_ACT = 209 * MiB;
constexpr size_t WS_XQ = WS_ACT, WS_XO = WS_ACT + 8 * MiB, WS_MKV = WS_ACT + 16 * MiB;
constexpr size_t WS_LR = 309 * MiB, WS_LA = 310 * MiB, WS_MIX = 326 * MiB, WS_KMEAN = 358 * MiB, WS_END = 359 * MiB;
constexpr int LDS_BYTES = 147456;

#define LAS __attribute__((address_space(3)))
typedef unsigned short bf16;
typedef unsigned v4u __attribute__((ext_vector_type(4)));
typedef unsigned v2u __attribute__((ext_vector_type(2)));
typedef float f32x4 __attribute__((ext_vector_type(4)));
typedef float f32x2 __attribute__((ext_vector_type(2)));
#define LDS_WAIT() asm volatile("s_waitcnt lgkmcnt(0)" ::: "memory")
__device__ __forceinline__ unsigned f2bf(float f) { unsigned u = __builtin_bit_cast(unsigned, f); return (u + 0x7fffu + ((u >> 16) & 1u)) >> 16; }
__device__ __forceinline__ unsigned pk2(float lo, float hi) { return f2bf(lo) | (f2bf(hi) << 16); }
__device__ __forceinline__ float bflo(unsigned u) { return __builtin_bit_cast(float, u << 16); }
__device__ __forceinline__ float bfhi(unsigned u) { return __builtin_bit_cast(float, u & 0xffff0000u); }
__device__ __forceinline__ float wave_sum(float v) {
#pragma unroll
    for (int o = 1; o < 64; o <<= 1) v += __shfl_xor(v, o);
    return v;
}


#ifndef ATT_NOMASK
#define ATT_NOMASK 0
#endif
#ifndef ATT_NOGATE
#define ATT_NOGATE 0
#endif
namespace att {
typedef unsigned short bf16;
using bf16x8 = __attribute__((ext_vector_type(8))) short;
using s16x4  = __attribute__((ext_vector_type(4))) short;
using f32x16 = __attribute__((ext_vector_type(16))) float;
using f32x4  = __attribute__((ext_vector_type(4))) float;
using u32x4  = __attribute__((ext_vector_type(4))) unsigned;
constexpr int   D = 128, NW = 8, QBLK = 32, KVBLK = 64;
constexpr float SCALE = 0.088388347648318440f;
constexpr float THR = 8.f;
constexpr size_t SHM_V = KVBLK * D * 2, SHM_K = KVBLK * D * 2, SHM_ATTN = 2 * SHM_V + 2 * SHM_K + NW * 64 * 4;
#define KSWZ(row, colB) ((row) * 256 + ((colB) ^ (((row) & 7) << 4)))
#define SBAR() __builtin_amdgcn_sched_barrier(0)
__device__ __forceinline__ int crow(int r, int hi) { return (r & 3) + 8 * (r >> 2) + 4 * hi; }
__device__ __forceinline__ unsigned cvtpk(float lo, float hi) { unsigned r; asm volatile("v_cvt_pk_bf16_f32 %0, %1, %2" : "=v"(r) : "v"(lo), "v"(hi)); return r; }
__device__ __forceinline__ float blo(unsigned u) { return __builtin_bit_cast(float, u << 16); }
__device__ __forceinline__ float bhi(unsigned u) { return __builtin_bit_cast(float, u & 0xffff0000u); }

__device__ __forceinline__ void partialSM(f32x16& p0, f32x16& p1, float& m_reg, float& mn, float& alpha) {
  constexpr float C = SCALE * 1.4426950408889634f;
  float pmax = p0[0]; for (int r = 1; r < 16; ++r) pmax = fmaxf(pmax, p0[r]); for (int r = 0; r < 16; ++r) pmax = fmaxf(pmax, p1[r]);
  { auto rr = __builtin_amdgcn_permlane32_swap(__float_as_uint(pmax), __float_as_uint(pmax), false, false);
    pmax = fmaxf(__uint_as_float(rr[0]), __uint_as_float(rr[1])); }
  if (__builtin_expect(__all(pmax - m_reg <= THR / SCALE), 1)) { mn = m_reg; alpha = 1.f; }
  else { mn = fmaxf(m_reg, pmax); alpha = __builtin_amdgcn_exp2f((m_reg - mn) * C); m_reg = mn; }
  float mnC = -mn * C;
  for (int r = 0; r < 16; ++r) p0[r] = fmaf(p0[r], C, mnC); for (int r = 0; r < 16; ++r) p1[r] = fmaf(p1[r], C, mnC);
  for (int r = 0; r < 16; ++r) p0[r] = __builtin_amdgcn_exp2f(p0[r]);
}
__device__ __forceinline__ void finishSM(f32x16& p0, f32x16& p1, float alpha, float& l_reg, bf16x8& pa0, bf16x8& pa1, bf16x8& pa2, bf16x8& pa3) {
  for (int r = 0; r < 16; ++r) p1[r] = __builtin_amdgcn_exp2f(p1[r]);
  float ps = 0; for (int r = 0; r < 16; ++r) ps += p0[r]; for (int r = 0; r < 16; ++r) ps += p1[r];
  { auto rr = __builtin_amdgcn_permlane32_swap(__float_as_uint(ps), __float_as_uint(ps), false, false);
    ps = __uint_as_float(rr[0]) + __uint_as_float(rr[1]); }
  l_reg = l_reg * alpha + ps;
#define PK4(P, BASE, OUT) do { unsigned a0 = cvtpk(P[BASE + 0], P[BASE + 1]), a1 = cvtpk(P[BASE + 2], P[BASE + 3]);   \
    unsigned b0 = cvtpk(P[BASE + 4], P[BASE + 5]), b1 = cvtpk(P[BASE + 6], P[BASE + 7]);                              \
    auto r0 = __builtin_amdgcn_permlane32_swap(a0, b0, false, false); auto r1 = __builtin_amdgcn_permlane32_swap(a1, b1, false, false); \
    u32x4 w = {r0[0], r1[0], r0[1], r1[1]}; OUT = *reinterpret_cast<bf16x8*>(&w); } while (0)
  PK4(p0, 0, pa0); PK4(p0, 8, pa1); PK4(p1, 0, pa2); PK4(p1, 8, pa3);
#undef PK4
}
__device__ __forceinline__ void qkt(f32x16& p0, f32x16& p1, const bf16* Ks, const bf16x8* qr, int r32, int hi) {
  p0 = f32x16{}; p1 = f32x16{};
  for (int d0 = 0; d0 < 8; ++d0) { int cb = (d0 * 16 + hi * 8) * 2;
    bf16x8 b0 = *reinterpret_cast<const bf16x8*>((const char*)Ks + KSWZ(r32, cb));
    bf16x8 b1 = *reinterpret_cast<const bf16x8*>((const char*)Ks + KSWZ(32 + r32, cb));
    p0 = __builtin_amdgcn_mfma_f32_32x32x16_bf16(b0, qr[d0], p0, 0, 0, 0);
    p1 = __builtin_amdgcn_mfma_f32_32x32x16_bf16(b1, qr[d0], p1, 0, 0, 0); }
}
__device__ __forceinline__ void qkt_l(f32x16& p0, f32x16& p1, const bf16* Ks, const char* Qs, int qrow, int r32, int hi) {
  p0 = f32x16{}; p1 = f32x16{};
  int qopq = 0; asm volatile("" : "+v"(qopq));
  for (int d0 = 0; d0 < 8; ++d0) { int cb = (d0 * 16 + hi * 8) * 2;
    bf16x8 b0 = *reinterpret_cast<const bf16x8*>((const char*)Ks + KSWZ(r32, cb));
    bf16x8 b1 = *reinterpret_cast<const bf16x8*>((const char*)Ks + KSWZ(32 + r32, cb));
    bf16x8 q = *reinterpret_cast<const bf16x8*>(Qs + qopq + KSWZ(qrow, cb));
    p0 = __builtin_amdgcn_mfma_f32_32x32x16_bf16(b0, q, p0, 0, 0, 0);
    p1 = __builtin_amdgcn_mfma_f32_32x32x16_bf16(b1, q, p1, 0, 0, 0); }
}
__device__ __forceinline__ int v_st(int k, int c) { const int kk = (k & ~0xC) | ((k & 4) << 1) | ((k & 8) >> 1); return ((kk >> 3) * 4 + (c >> 5)) * 512 + ((kk & 7) * 32 + (c & 31)) * 2; }
__device__ __forceinline__ int v_rd_base(int lane) { return ((lane & 3) << 3) | (((lane >> 2) & 3) << 6) | (((lane >> 4) & 1) << 5) | (((lane >> 5) & 1) << 8); }
constexpr int v_rd_off(int d0, int ks, int half) { return d0 * 512 + ks * 4096 + half * 2048; }
template <int OFF> __device__ __forceinline__ s16x4 tr_read(int vb) {
  s16x4 r; asm volatile("ds_read_b64_tr_b16 %0, %1 offset:%2" : "=&v"(r) : "v"(vb), "i"(OFF) : "memory"); return r;
}
template <int D0> __device__ __forceinline__ void pv_one(f32x16& od, int vb, bf16x8 pa0, bf16x8 pa1, bf16x8 pa2, bf16x8 pa3) {
  const s16x4 l0 = tr_read<v_rd_off(D0, 0, 0)>(vb), h0 = tr_read<v_rd_off(D0, 0, 1)>(vb), l1 = tr_read<v_rd_off(D0, 1, 0)>(vb), h1 = tr_read<v_rd_off(D0, 1, 1)>(vb);
  const s16x4 l2 = tr_read<v_rd_off(D0, 2, 0)>(vb), h2 = tr_read<v_rd_off(D0, 2, 1)>(vb), l3 = tr_read<v_rd_off(D0, 3, 0)>(vb), h3 = tr_read<v_rd_off(D0, 3, 1)>(vb);
  asm volatile("s_waitcnt lgkmcnt(0)" ::: "memory"); SBAR();
#define PK(L, H) (bf16x8){L[0], L[1], L[2], L[3], H[0], H[1], H[2], H[3]}
  od = __builtin_amdgcn_mfma_f32_32x32x16_bf16(pa0, PK(l0, h0), od, 0, 0, 0);
  od = __builtin_amdgcn_mfma_f32_32x32x16_bf16(pa1, PK(l1, h1), od, 0, 0, 0);
  od = __builtin_amdgcn_mfma_f32_32x32x16_bf16(pa2, PK(l2, h2), od, 0, 0, 0);
  od = __builtin_amdgcn_mfma_f32_32x32x16_bf16(pa3, PK(l3, h3), od, 0, 0, 0);
#undef PK
}
__device__ __forceinline__ void pv_d0(f32x16* o, int vb, bf16x8 pa0, bf16x8 pa1, bf16x8 pa2, bf16x8 pa3) {
  pv_one<0>(o[0], vb, pa0, pa1, pa2, pa3); pv_one<1>(o[1], vb, pa0, pa1, pa2, pa3); pv_one<2>(o[2], vb, pa0, pa1, pa2, pa3); pv_one<3>(o[3], vb, pa0, pa1, pa2, pa3);
}
__device__ __forceinline__ bf16x8 knorm8(bf16x8 v, const float* g) {
  const u32x4 w = *reinterpret_cast<const u32x4*>(&v);
  float f[8] = {blo(w.x), bhi(w.x), blo(w.y), bhi(w.y), blo(w.z), bhi(w.z), blo(w.w), bhi(w.w)};
  float ss = 0.f;
#pragma unroll
  for (int i = 0; i < 8; ++i) ss += f[i] * f[i];
  ss += __shfl_xor(ss, 1); ss += __shfl_xor(ss, 2); ss += __shfl_xor(ss, 4); ss += __shfl_xor(ss, 8);
  const float rs = rsqrtf(ss * (1.0f / 128.0f) + 1e-6f);
  u32x4 o = {cvtpk(f[0] * rs * g[0], f[1] * rs * g[1]), cvtpk(f[2] * rs * g[2], f[3] * rs * g[3]), cvtpk(f[4] * rs * g[4], f[5] * rs * g[5]), cvtpk(f[6] * rs * g[6], f[7] * rs * g[7])};
  return *reinterpret_cast<bf16x8*>(&o);
}

template <int LDQ, int LDK, int LDO, int MODE, int SD, int VOFFB, bool PIPE, bool QL>
__device__ __forceinline__ void attn_body(const bf16* __restrict__ Qb, const bf16* __restrict__ Kh, bf16* __restrict__ Ob, int seq, char* lds,
                                          const float* __restrict__ gq, const float* __restrict__ gk, const float* __restrict__ kmean, int qblk) {
  const int tid = threadIdx.x, wid = tid >> 6, lane = tid & 63, r32 = lane & 31, hi = lane >> 5;
  bf16* V_lds = (bf16*)lds; bf16* K_lds = (bf16*)(lds + 2 * SHM_V);
  float* ws = (float*)(lds + 2 * SHM_V + 2 * SHM_K) + wid * 64; float* li_l = ws; float* al_l = ws + 32;
  float m_reg = -1e30f, l_reg = 0; f32x16 o[4] = {}; bf16x8 qr[8];
  const bf16* Qw = Qb + (long)(wid * QBLK + r32) * LDQ + hi * 8;
#pragma unroll
  for (int d0 = 0; d0 < 8; ++d0) qr[d0] = *reinterpret_cast<const bf16x8*>(Qw + d0 * 16);
  unsigned sel = 0;
  if constexpr (MODE == 0) {
    float ss = 0.f;
#pragma unroll
    for (int d0 = 0; d0 < 8; ++d0) { const u32x4 w = *reinterpret_cast<const u32x4*>(&qr[d0]);
      const float f[8] = {blo(w.x), bhi(w.x), blo(w.y), bhi(w.y), blo(w.z), bhi(w.z), blo(w.w), bhi(w.w)};
#pragma unroll
      for (int i = 0; i < 8; ++i) ss += f[i] * f[i]; }
    ss += __shfl_xor(ss, 32);
    const float rs = rsqrtf(ss * (1.0f / 128.0f) + 1e-6f);
#pragma unroll
    for (int d0 = 0; d0 < 8; ++d0) { const u32x4 w = *reinterpret_cast<const u32x4*>(&qr[d0]);
      const f32x4 g0 = *reinterpret_cast<const f32x4*>(gq + d0 * 16 + hi * 8), g1 = *reinterpret_cast<const f32x4*>(gq + d0 * 16 + hi * 8 + 4);
      u32x4 ow = {cvtpk(blo(w.x) * rs * g0[0], bhi(w.x) * rs * g0[1]), cvtpk(blo(w.y) * rs * g0[2], bhi(w.y) * rs * g0[3]), cvtpk(blo(w.z) * rs * g1[0], bhi(w.z) * rs * g1[1]), cvtpk(blo(w.w) * rs * g1[2], bhi(w.w) * rs * g1[3])};
      qr[d0] = *reinterpret_cast<bf16x8*>(&ow); }
  }
  if constexpr (MODE == 1 && !ATT_NOGATE) {
    float* km_l = (float*)(lds + SHM_ATTN + 512 + 65536);
    *reinterpret_cast<f32x4*>(km_l + tid * 4) = *reinterpret_cast<const f32x4*>(kmean + tid * 4); __syncthreads();
    float b1 = -3e38f, b2 = -3e38f, b3 = -3e38f; int i1 = -1, i2 = -1, i3 = -1;
#pragma unroll 1
    for (int n = 0; n < qblk; ++n) { float acc = 0.f;
#pragma unroll
      for (int d0 = 0; d0 < 8; ++d0) { const u32x4 w = *reinterpret_cast<const u32x4*>(&qr[d0]); const float* kp = km_l + n * 128 + d0 * 16 + hi * 8;
        const f32x4 k0 = *reinterpret_cast<const f32x4*>(kp), k1 = *reinterpret_cast<const f32x4*>(kp + 4);
        acc += blo(w.x) * k0[0] + bhi(w.x) * k0[1] + blo(w.y) * k0[2] + bhi(w.y) * k0[3] + blo(w.z) * k1[0] + bhi(w.z) * k1[1] + blo(w.w) * k1[2] + bhi(w.w) * k1[3]; }
      acc += __shfl_xor(acc, 32);
      if (acc > b1) { b3 = b2; i3 = i2; b2 = b1; i2 = i1; b1 = acc; i1 = n; } else if (acc > b2) { b3 = b2; i3 = i2; b2 = acc; i2 = n; } else if (acc > b3) { b3 = acc; i3 = n; } }
    sel = (i1 >= 0 ? 1u << i1 : 0u) | (i2 >= 0 ? 1u << i2 : 0u) | (i3 >= 0 ? 1u << i3 : 0u);
    asm volatile("" : "+v"(sel));
  }
  const char* Q_lds = lds + SHM_ATTN + 512; const int qrow = wid * QBLK + r32;
  if constexpr (QL) {
#pragma unroll
    for (int d0 = 0; d0 < 8; ++d0) *reinterpret_cast<bf16x8*>((char*)Q_lds + KSWZ(qrow, (d0 * 16 + hi * 8) * 2)) = qr[d0];
  }
#define QKT(P0, P1, KS) do { if constexpr (QL) qkt_l(P0, P1, KS, Q_lds, qrow, r32, hi); else qkt(P0, P1, KS, qr, r32, hi); } while (0)
  const int sr = tid >> 4, sc = (tid & 15) * 8, vst0 = v_st(sr, sc), vst1 = v_st(32 + sr, sc);
  const float* gk_l = (const float*)(lds + SHM_ATTN);
  if constexpr (MODE == 0) { if (tid < 128) ((float*)(lds + SHM_ATTN))[tid] = gk[tid]; __syncthreads(); }
  const int vb0 = (int)(uintptr_t)V_lds + v_rd_base(lane);
  struct { bf16x8 vs0, vs1, ks0, ks1; } sr_[2];
  const unsigned toff = (unsigned)(sr * LDK + sc) * 2u;
#define SLOAD(i, k0) do { const char* kb_ = (const char*)Kh + (size_t)(k0) * (size_t)(LDK * 2); \
    sr_[i].vs0 = *reinterpret_cast<const bf16x8*>(kb_ + VOFFB + toff); sr_[i].vs1 = *reinterpret_cast<const bf16x8*>(kb_ + (VOFFB + 32 * LDK * 2) + toff); \
    sr_[i].ks0 = *reinterpret_cast<const bf16x8*>(kb_ + toff); sr_[i].ks1 = *reinterpret_cast<const bf16x8*>(kb_ + (32 * LDK * 2) + toff); } while (0)
#define KN(x) ((MODE == 0) ? knorm8((x), gk_l + sc) : (x))
#define SWRITE(b, i) do { *(bf16x8*)((char*)V_lds + (b) * SHM_V + vst0) = sr_[i].vs0;          \
    *(bf16x8*)((char*)V_lds + (b) * SHM_V + vst1) = sr_[i].vs1; int kc = sc * 2;               \
    *(bf16x8*)((char*)K_lds + (b) * SHM_K + KSWZ(sr, kc)) = KN(sr_[i].ks0);                       \
    *(bf16x8*)((char*)K_lds + (b) * SHM_K + KSWZ(32 + sr, kc)) = KN(sr_[i].ks1); } while (0)
#define SWAIT() do { if constexpr (SD == 2) asm volatile("s_waitcnt vmcnt(4)" ::: "memory"); else asm volatile("s_waitcnt vmcnt(0)" ::: "memory"); } while (0)
#define RESC(a) do { if (__any((a) < 1.f)) { if (hi == 0) al_l[r32] = (a); asm volatile("s_waitcnt lgkmcnt(0)" ::: "memory"); \
    for (int d = 0; d < 4; ++d) for (int r = 0; r < 16; ++r) o[d][r] *= al_l[crow(r, hi)]; } } while (0)
#define MASK(P0, P1, tile) do { if constexpr (MODE == 1 && !ATT_NOMASK) { const int nb_ = (tile) >> 2; const float ninf_ = -__builtin_inff(); \
    if (nb_ < qblk) { if (!((sel >> nb_) & 1u)) { for (int r = 0; r < 16; ++r) { P0[r] = ninf_; P1[r] = ninf_; } } } \
    else { const int thr_ = rowthr - ((tile) & 3) * 64;     \
      for (int r = 0; r < 16; ++r) { const int c_ = (r & 3) + 8 * (r >> 2); if (c_ > thr_) P0[r] = ninf_; if (c_ + 32 > thr_) P1[r] = ninf_; } } } } while (0)
  const int rowthr = wid * 32 + r32 - 4 * hi;
  const int NT = seq / KVBLK;
  if constexpr (PIPE) {
  f32x16 pA0, pA1, pB0, pB1; float mnA, mnB, alA, alB; bf16x8 pa0, pa1, pa2, pa3;
  constexpr int SE = 0, SO = SD - 1;
  SLOAD(SE, 0); asm volatile("s_waitcnt vmcnt(0)" ::: "memory"); SWRITE(0, SE); __syncthreads();
  QKT(pA0, pA1, K_lds); MASK(pA0, pA1, 0); partialSM(pA0, pA1, m_reg, mnA, alA);
  SLOAD(SO, KVBLK); if constexpr (SD == 2) { if (2 < NT) SLOAD(SE, 2 * KVBLK); }
  SWAIT(); SWRITE(1, SO); __syncthreads();
  for (int j = 1; j + 1 < NT; j += 2) {
    SBAR(); QKT(pB0, pB1, (bf16*)((char*)K_lds + SHM_K)); MASK(pB0, pB1, j);
    finishSM(pA0, pA1, alA, l_reg, pa0, pa1, pa2, pa3); SBAR();
    SLOAD(SO, (j + SD) * KVBLK); SBAR();
    pv_d0(o, vb0, pa0, pa1, pa2, pa3); partialSM(pB0, pB1, m_reg, mnB, alB);
    __syncthreads(); SWAIT(); SWRITE(0, SE);
    RESC(alB); __syncthreads();
    SBAR(); QKT(pA0, pA1, K_lds); MASK(pA0, pA1, j + 1);
    finishSM(pB0, pB1, alB, l_reg, pa0, pa1, pa2, pa3); SBAR();
    if (SD == 1 || j + 3 < NT) SLOAD(SE, (j + 1 + SD) * KVBLK); SBAR();
    pv_d0(o, vb0 + (int)SHM_V, pa0, pa1, pa2, pa3); partialSM(pA0, pA1, m_reg, mnA, alA);
    __syncthreads(); SWAIT(); SWRITE(1, SO);
    RESC(alA); __syncthreads();
  }
  SBAR(); QKT(pB0, pB1, (bf16*)((char*)K_lds + SHM_K)); MASK(pB0, pB1, NT - 1);
  finishSM(pA0, pA1, alA, l_reg, pa0, pa1, pa2, pa3); SBAR();
  pv_d0(o, vb0, pa0, pa1, pa2, pa3); partialSM(pB0, pB1, m_reg, mnB, alB);
  __syncthreads(); RESC(alB);
  finishSM(pB0, pB1, alB, l_reg, pa0, pa1, pa2, pa3); SBAR();
  pv_d0(o, vb0 + (int)SHM_V, pa0, pa1, pa2, pa3);
  } else {
    f32x16 p0, p1; float mn, al; bf16x8 pa0, pa1, pa2, pa3;
#define TILE(buf, t) do { SBAR(); QKT(p0, p1, (bf16*)((char*)K_lds + (buf) * SHM_K)); MASK(p0, p1, (t)); \
      partialSM(p0, p1, m_reg, mn, al); finishSM(p0, p1, al, l_reg, pa0, pa1, pa2, pa3); RESC(al); SBAR(); \
      pv_d0(o, vb0 + (buf) * (int)SHM_V, pa0, pa1, pa2, pa3); } while (0)
    SLOAD(0, 0); asm volatile("s_waitcnt vmcnt(0)" ::: "memory"); SWRITE(0, 0); __syncthreads();
    SLOAD(1, KVBLK);
#pragma unroll 1
    for (int t = 0; t < NT; t += 2) {
      if (t + 2 < NT) SLOAD(0, (t + 2) * KVBLK);
      TILE(0, t);
      SWRITE(1, 1); __syncthreads();
      if (t + 3 < NT) SLOAD(1, (t + 3) * KVBLK);
      TILE(1, t + 1);
      if (t + 2 < NT) SWRITE(0, 0);
      __syncthreads();
    }
#undef TILE
  }
  if (hi == 0) li_l[r32] = l_reg; asm volatile("s_waitcnt lgkmcnt(0)" ::: "memory");
  float rli[16];
#pragma unroll
  for (int r = 0; r < 16; ++r) rli[r] = __builtin_amdgcn_rcpf(li_l[crow(r, hi)]);
  bf16* Ow = Ob + (long)(wid * QBLK) * LDO;
#pragma unroll
  for (int r = 0; r < 16; ++r) { int orow = crow(r, hi);
    for (int d0 = 0; d0 < 4; ++d0) Ow[(long)orow * LDO + d0 * 32 + r32] = (bf16)(cvtpk(o[d0][r] * rli[r], 0.f) & 0xffffu); }
  __syncthreads();
#undef SLOAD
#undef KN
#undef SWRITE
#undef SWAIT
#undef RESC
#undef MASK
#undef QKT
}
#undef KSWZ
#undef SBAR
}
struct Args { const float* in[25]; float* out; unsigned char* ws; int lo1, hi1, lo2, hi2; };

__device__ __forceinline__ void transpose_item(const float* W, int K, int N, bf16* WT, int dst_row0, LAS float* scr, int k0, int n0, int lane) {
    const int nn = n0 + (lane & 31); const bool ok = nn < N;
#pragma unroll 8
    for (int i = 0; i < 32; ++i) { const int kk = 2 * i + (lane >> 5); scr[kk * 33 + (lane & 31)] = ok ? W[(size_t)(k0 + kk) * N + nn] : 0.f; }
    LDS_WAIT(); asm volatile("" ::: "memory");
    const int c = lane & 7;
#pragma unroll
    for (int j = 0; j < 4; ++j) { const int n = (lane >> 3) + 8 * j; const LAS float* s = scr + (8 * c) * 33 + n;
        v4u o; o.x = pk2(s[0 * 33], s[1 * 33]); o.y = pk2(s[2 * 33], s[3 * 33]); o.z = pk2(s[4 * 33], s[5 * 33]); o.w = pk2(s[6 * 33], s[7 * 33]);
        *(v4u*)(WT + (size_t)(dst_row0 + n) * K + k0 + 8 * c) = o; }
    LDS_WAIT(); asm volatile("" ::: "memory");
}

#define XB_TMO      128
#define XB_XCNT(j)  (256  + 64 * (j))
#define XB_XSUB(j)  (1280 + 64 * (j))
#define XB_XGEN(j)  (2304 + 64 * (j))
#define XB_TOP      3328
#define XB_TOPGEN   3392
#define XCD_BAR_WORDS 3456
#define XB_SPIN_CAP (1u << 18)

__device__ __forceinline__ unsigned xb_ld(unsigned* p)              { return __hip_atomic_load(p, __ATOMIC_RELAXED, __HIP_MEMORY_SCOPE_AGENT); }
__device__ __forceinline__ unsigned xb_add(unsigned* p, unsigned v) { return __hip_atomic_fetch_add(p, v, __ATOMIC_RELAXED, __HIP_MEMORY_SCOPE_AGENT); }
__device__ __forceinline__ unsigned xb_xcc_id() { return (unsigned)__builtin_amdgcn_s_getreg((3 << 11) | 20) & 0xFu; }
#define XB_SPIN(cond, bar) do { unsigned _sp = 0; while (cond) { __builtin_amdgcn_s_sleep(1); \
    if ((++_sp & 255u) == 0u) { if (xb_ld(&(bar)[XB_TMO])) break; if (_sp > XB_SPIN_CAP) { atomicAdd(&(bar)[XB_TMO], 1u); break; } } } } while (0)

struct XcdBarrier {
    unsigned* bar; unsigned x;
    volatile LAS unsigned* st;
};

__device__ __forceinline__ XcdBarrier xcd_barrier_post(unsigned* bar, volatile LAS unsigned* st) {
    XcdBarrier b; b.bar = bar; b.x = xb_xcc_id(); b.st = st;
    if (threadIdx.x == 0) (void)xb_add(&bar[XB_XCNT(b.x)], 1u);
    return b;
}
__device__ __forceinline__ void xcd_barrier_complete(unsigned* bar, unsigned x, unsigned& nloc, unsigned& nx) {
    const unsigned G = gridDim.x * gridDim.y * gridDim.z;
    unsigned sum, cnt, mine, sp = 0u;
    for (;;) {
        sum = 0u; cnt = 0u; mine = 0u;
#pragma unroll
        for (unsigned j = 0; j < 16; ++j) { const unsigned c = xb_ld(&bar[XB_XCNT(j)]); sum += c; cnt += (c > 0u) ? 1u : 0u; mine = (j == x) ? c : mine; }
        if (sum == G) break;
        __builtin_amdgcn_s_sleep(1);
        if ((++sp & 255u) == 0u) { if (xb_ld(&bar[XB_TMO])) break; if (sp > XB_SPIN_CAP) { atomicAdd(&bar[XB_TMO], 1u); break; } }
    }
    nloc = mine > 0u ? mine : 1u; nx = cnt > 0u ? cnt : 1u;
}

__device__ __forceinline__ void xcd_barrier(const XcdBarrier& b) {
    asm volatile("s_waitcnt vmcnt(0)" ::: "memory");
    __syncthreads();
    if (threadIdx.x == 0) {
        unsigned* bar = b.bar;
        __builtin_amdgcn_s_waitcnt(0);
        unsigned nloc = b.st[0], nx = b.st[1];
        if (nloc == 0u) { xcd_barrier_complete(bar, b.x, nloc, nx); b.st[0] = nloc; b.st[1] = nx; }
        const unsigned old = xb_add(&bar[XB_XSUB(b.x)], 1u);
        const unsigned gen = old / nloc;
        if (old + 1u == (gen + 1u) * nloc) {
            __builtin_amdgcn_fence(__ATOMIC_RELEASE, "agent");
            asm volatile("s_waitcnt vmcnt(0)" ::: "memory");
            const unsigned og = xb_add(&bar[XB_TOP], 1u);
            const unsigned tg = og / nx;
            if (og + 1u == (tg + 1u) * nx) xb_add(&bar[XB_TOPGEN], 1u);
            else XB_SPIN(xb_ld(&bar[XB_TOPGEN]) == tg, bar);
            __builtin_amdgcn_fence(__ATOMIC_ACQUIRE, "agent");
            xb_add(&bar[XB_XGEN(b.x)], 1u);
            asm volatile("s_waitcnt vmcnt(0)" ::: "memory");
        } else {
            XB_SPIN(xb_ld(&bar[XB_XGEN(b.x)]) == gen, bar);
            __builtin_amdgcn_fence(__ATOMIC_ACQUIRE, "agent");
            asm volatile("s_waitcnt vmcnt(0)" ::: "memory");
        }
    }
    __syncthreads();
}
struct Item { const float* W; bf16* WT; int K, N, k0, n0, drow; };
constexpr int IT_GU = (D_ / 64) * (FF_ / 128), IT_DN = (FF_ / 64) * (D_ / 128), IT_IN = (D_ / 64) * (NINP / 128), IT_OUT = (D_ / 64) * (D_ / 128), IT_Q = (D_ / 64) * (512 / 128), IT_KV = (D_ / 64) * (1024 / 128), IT_O = (512 / 64) * (D_ / 128);
constexpr int IL_W1GU = 0, IL_W1D = 2 * IT_GU, IL_WIN = IL_W1D + IT_DN, IL_WOUT = IL_WIN + IT_IN, IL_WQ = IL_WOUT + IT_OUT, IL_WKV = IL_WQ + IT_Q, IL_WO = IL_WKV + IT_KV, IL_W2GU = IL_WO + IT_O, IL_W2D = IL_W2GU + 2 * IT_GU, IL_END = IL_W2D + IT_DN;
__device__ __forceinline__ void decode_item(int r, const Args& a, unsigned char* ws, Item& it) {
    const float* W; bf16* WT; int K, N, NP, mode = 0;
    if (r < IL_W1D) { const bool up = r >= IT_GU; r -= up ? IT_GU : 0; W = a.in[up ? 4 : 3]; WT = (bf16*)(ws + WS_W1GU); K = D_; N = FF_; NP = FF_; mode = up ? 2 : 1; }
    else if (r < IL_WIN) { r -= IL_W1D; W = a.in[5]; WT = (bf16*)(ws + WS_W1D); K = FF_; N = D_; NP = D_; }
    else if (r < IL_WOUT) { r -= IL_WIN; W = a.in[7]; WT = (bf16*)(ws + WS_WIN); K = D_; N = NIN; NP = NINP; }
    else if (r < IL_WQ) { r -= IL_WOUT; W = a.in[13]; WT = (bf16*)(ws + WS_WOUT); K = D_; N = D_; NP = D_; }
    else if (r < IL_WKV) { r -= IL_WQ; W = a.in[16]; WT = (bf16*)(ws + WS_WQ); K = D_; N = 512; NP = 512; }
    else if (r < IL_WO) { r -= IL_WKV; W = a.in[17]; WT = (bf16*)(ws + WS_WKV); K = D_; N = 1024; NP = 1024; }
    else if (r < IL_W2GU) { r -= IL_WO; W = a.in[18]; WT = (bf16*)(ws + WS_WO); K = 512; N = D_; NP = D_; }
    else if (r < IL_W2D) { r -= IL_W2GU; const bool up = r >= IT_GU; r -= up ? IT_GU : 0; W = a.in[up ? 23 : 22]; WT = (bf16*)(ws + WS_W2GU); K = D_; N = FF_; NP = FF_; mode = up ? 2 : 1; }
    else { r -= IL_W2D; W = a.in[24]; WT = (bf16*)(ws + WS_W2D); K = FF_; N = D_; NP = D_; }
    const int nblk = NP / 128, kb = r / nblk, nb = r - kb * nblk, n0 = nb * 128;
    it.W = W; it.WT = WT; it.K = K; it.N = N; it.k0 = kb * 64; it.n0 = n0;
    it.drow = mode ? nb * 256 + (mode == 2 ? 128 : 0) : n0;
}
__device__ __forceinline__ void item_convert(const Item& it, int lane) {
    const int nn = it.n0 + 2 * lane; const bool ok = nn < it.N;
    const f32x2* p = (const f32x2*)(it.W + (size_t)it.k0 * it.N + (ok ? nn : 0)); const size_t st = (size_t)(it.N >> 1);
    f32x2 v[64];
#pragma unroll
    for (int i = 0; i < 64; ++i) v[i] = p[i * st];
    if (!ok) {
#pragma unroll
        for (int i = 0; i < 64; ++i) v[i] = (f32x2){0.f, 0.f}; }
    int dr = it.drow + 2 * lane;
    if (it.N == NIN) dr = nn < 3072 ? nn : (nn < 3088 ? 6144 + (nn - 3072) : (nn < NIN ? nn - 16 : nn));
    bf16* o0 = it.WT + (size_t)dr * it.K + it.k0; bf16* o1 = o0 + it.K;
#pragma unroll
    for (int j = 0; j < 8; ++j) {
        v4u x0, x1;
        x0.x = pg8::cvt_pk_bf16(v[8 * j][0], v[8 * j + 1][0]); x0.y = pg8::cvt_pk_bf16(v[8 * j + 2][0], v[8 * j + 3][0]); x0.z = pg8::cvt_pk_bf16(v[8 * j + 4][0], v[8 * j + 5][0]); x0.w = pg8::cvt_pk_bf16(v[8 * j + 6][0], v[8 * j + 7][0]);
        x1.x = pg8::cvt_pk_bf16(v[8 * j][1], v[8 * j + 1][1]); x1.y = pg8::cvt_pk_bf16(v[8 * j + 2][1], v[8 * j + 3][1]); x1.z = pg8::cvt_pk_bf16(v[8 * j + 4][1], v[8 * j + 5][1]); x1.w = pg8::cvt_pk_bf16(v[8 * j + 6][1], v[8 * j + 7][1]);
        *(v4u*)(o0 + 8 * j) = x0; *(v4u*)(o1 + 8 * j) = x1; }
}
__device__ __forceinline__ void convert_range(int lo, int hi, int first, int stride, const Args& a, unsigned char* ws, LAS float* scr, int lane) {
#pragma unroll 1
    for (int r = lo + first; r < hi; r += stride) { Item it; decode_item(r, a, ws, it); item_convert(it, lane); }
}

template <bool KNORM>
__device__ __forceinline__ void attn_block(const bf16* K, const bf16* V, int ld, int limit, float q0, float q1, float& m, float& l, float& o0, float& o1, LAS float* sc, int lane) {
    float bm = -1e30f;
    limit = __builtin_amdgcn_readfirstlane(limit);
    for (int key = 0; key < limit; ++key) {
        const unsigned kk = *(const unsigned*)(K + (size_t)key * ld + 2 * lane);
        const float k0 = bflo(kk), k1 = bfhi(kk);
        float s = wave_sum(q0 * k0 + q1 * k1);
        if (KNORM) { const float ss = wave_sum(k0 * k0 + k1 * k1); s *= rsqrtf(ss * (1.0f / 128.0f) + EPS); }
        if (lane == 0) sc[key] = s;
        bm = fmaxf(bm, s);
    }
    const float mn = fmaxf(m, bm), corr = __expf(m - mn);
    l *= corr; o0 *= corr; o1 *= corr;
    LDS_WAIT();
    for (int key = 0; key < limit; ++key) {
        const float p = __expf(sc[key] - mn); l += p;
        const unsigned vv = *(const unsigned*)(V + (size_t)key * ld + 2 * lane);
        o0 += p * bflo(vv); o1 += p * bfhi(vv);
    }
    LDS_WAIT();
    m = mn;
}

typedef short bf16x8_t __attribute__((ext_vector_type(8)));
constexpr int KTS = 72, QS = 136;
constexpr size_t WS_UPDT = WS_W1GU, WS_SPT = WS_XN, WS_DEC = WS_KMEAN + 512 * 1024;
__device__ __forceinline__ float logsig(float x) { return fminf(x, 0.f) - log1pf(__expf(-fabsf(x))); }
__device__ __forceinline__ void load_vt(const bf16* U, size_t row0, int vcol, LAS bf16* VTw, int lane) {
    const v4u* p = (const v4u*)(U + (row0 + lane) * NINP + vcol);
#pragma unroll
    for (int c = 0; c < 4; ++c) { const v4u x = p[c]; const unsigned w[4] = {x.x, x.y, x.z, x.w};
#pragma unroll
        for (int e = 0; e < 4; ++e) { VTw[(c * 8 + 2 * e) * KTS + lane] = (bf16)(w[e] & 0xffffu); VTw[(c * 8 + 2 * e + 1) * KTS + lane] = (bf16)(w[e] >> 16); } }
}
__device__ __forceinline__ void gla_a(int task, const bf16* U, const float* LR, const float* w2, const float* b2, float* BCUM, float* DEC, float* UPDT, LAS unsigned char* lds, int tid) {
    const int lane = tid & 63, wave = tid >> 6, l15 = lane & 15, lq = lane >> 4;
    const int bh = task >> 6, n = task & 63, b = bh >> 2, h = bh & 3; const size_t row0 = (size_t)b * T_ + n * 64;
    LAS bf16* KT = (LAS bf16*)lds;
    LAS float* segtot = (LAS float*)(lds + 18432);
    LAS bf16* VTw = (LAS bf16*)(lds + 20480 + wave * 4608);
    const int d = tid & 127, ig = tid >> 7;
    float w2c[16];
#pragma unroll
    for (int j = 0; j < 16; ++j) w2c[j] = w2[j * 512 + h * 128 + d];
    const float bias = b2[h * 128 + d];
    float c[16]; float run = 0.f;
#pragma unroll
    for (int ii = 0; ii < 16; ++ii) { const f32x4* lr = (const f32x4*)(LR + (row0 + ig * 16 + ii) * 16); float acc = bias;
#pragma unroll
        for (int j4 = 0; j4 < 4; ++j4) { const f32x4 v = lr[j4]; acc += v[0] * w2c[4 * j4] + v[1] * w2c[4 * j4 + 1] + v[2] * w2c[4 * j4 + 2] + v[3] * w2c[4 * j4 + 3]; }
        run += logsig(acc) * (1.0f / 16.0f); c[ii] = run; }
    segtot[ig * 128 + d] = run;
    load_vt(U, row0, GV_OFF + h * 256 + 32 * wave, VTw, lane);
    __syncthreads();
    const float s0 = segtot[d], s1 = segtot[128 + d], s2 = segtot[256 + d], s3 = segtot[384 + d];
    const float pre = ((ig > 0 ? s0 : 0.f) + (ig > 1 ? s1 : 0.f)) + (ig > 2 ? s2 : 0.f), blast = ((s0 + s1) + s2) + s3;
    unsigned short kraw[16];
#pragma unroll
    for (int ii = 0; ii < 16; ++ii) kraw[ii] = U[(row0 + ig * 16 + ii) * NINP + GK_OFF + h * 128 + d];
    asm volatile("" ::: "memory");
    unsigned pk[8];
#pragma unroll
    for (int ii = 0; ii < 16; ii += 2) { float kt[2];
#pragma unroll
        for (int e = 0; e < 2; ++e) { const size_t row = row0 + ig * 16 + ii + e; const float bc = pre + c[ii + e];
            BCUM[row * 512 + h * 128 + d] = bc;
            kt[e] = bflo((unsigned)kraw[ii + e]) * __expf(blast - bc); }
        pk[ii >> 1] = pk2(kt[0], kt[1]); }
    *(LAS v4u*)(KT + d * KTS + ig * 16) = (v4u){pk[0], pk[1], pk[2], pk[3]};
    *(LAS v4u*)(KT + d * KTS + ig * 16 + 8) = (v4u){pk[4], pk[5], pk[6], pk[7]};
    if (ig == 0) DEC[(size_t)task * 128 + d] = __expf(blast);
    __syncthreads();
    f32x4 acc[8][2];
#pragma unroll
    for (int dt = 0; dt < 8; ++dt) { acc[dt][0] = (f32x4){0.f, 0.f, 0.f, 0.f}; acc[dt][1] = (f32x4){0.f, 0.f, 0.f, 0.f}; }
#pragma unroll
    for (int ks = 0; ks < 2; ++ks) {
        const bf16x8_t B0 = *(const LAS bf16x8_t*)(VTw + (l15) * KTS + ks * 32 + 8 * lq), B1 = *(const LAS bf16x8_t*)(VTw + (16 + l15) * KTS + ks * 32 + 8 * lq);
#pragma unroll
        for (int dt = 0; dt < 8; ++dt) { const bf16x8_t A = *(const LAS bf16x8_t*)(KT + (dt * 16 + l15) * KTS + ks * 32 + 8 * lq);
            acc[dt][0] = __builtin_amdgcn_mfma_f32_16x16x32_bf16(A, B0, acc[dt][0], 0, 0, 0); acc[dt][1] = __builtin_amdgcn_mfma_f32_16x16x32_bf16(A, B1, acc[dt][1], 0, 0, 0); } }
    float* up = UPDT + (size_t)task * 32768;
#pragma unroll
    for (int dt = 0; dt < 8; ++dt)
#pragma unroll
        for (int nt = 0; nt < 2; ++nt) *(f32x4*)(up + (32 * wave + nt * 16 + l15) * 128 + dt * 16 + lq * 4) = acc[dt][nt];
    __syncthreads();
}
__device__ __forceinline__ void gla_scan(int idx, const float* __restrict__ UPDT, const float* __restrict__ DEC, bf16* __restrict__ SPT) {
    const int d4 = idx & 31, v = (idx >> 5) & 255, bh = idx >> 13;
    f32x4 S = (f32x4){0.f, 0.f, 0.f, 0.f};
    const size_t e0 = (size_t)v * 128 + d4 * 4;
#pragma unroll 1
    for (int n0 = 0; n0 < 64; n0 += 16) {
        f32x4 u[16], dc[16];
#pragma unroll
        for (int j = 0; j < 16; ++j) { const size_t task = (size_t)bh * 64 + n0 + j; u[j] = *(const f32x4*)(UPDT + task * 32768 + e0); dc[j] = *(const f32x4*)(DEC + task * 128 + d4 * 4); }
        asm volatile("" ::: "memory");
#pragma unroll
        for (int j = 0; j < 16; ++j) { const size_t task = (size_t)bh * 64 + n0 + j;
            v2u pk; pk.x = pg8::cvt_pk_bf16(S[0], S[1]); pk.y = pg8::cvt_pk_bf16(S[2], S[3]); *(v2u*)(SPT + task * 32768 + e0) = pk;
            S = dc[j] * S + u[j]; }
    }
}
__device__ __forceinline__ void gla_c(int task, const bf16* U, const float* BCUM, const bf16* SPT, const float* gout, bf16* MIX, LAS unsigned char* lds, int tid) {
    const int lane = tid & 63, wave = tid >> 6, l15 = lane & 15, lq = lane >> 4;
    const int bh = task >> 6, n = task & 63, b = bh >> 2, h = bh & 3; const size_t row0 = (size_t)b * T_ + n * 64;
    LAS bf16* QD = (LAS bf16*)lds;
    LAS bf16* KI = (LAS bf16*)(lds + 17408);
    LAS bf16* ATT = (LAS bf16*)(lds + 34816);
    LAS float* SSQ = (LAS float*)(lds + 44032);
    LAS bf16* VTw = (LAS bf16*)(lds + 46080 + wave * 4608);
    const int d = tid & 127, ig = tid >> 7;
    { v4u q8[2], k8[2]; f32x4 bc0[2], bc1[2];
#pragma unroll
      for (int rep = 0; rep < 2; ++rep) { const int idx = tid + NTHR * rep, i = idx >> 4, c8 = (idx & 15) * 8; const size_t row = row0 + i;
          q8[rep] = *(const v4u*)(U + row * NINP + GQ_OFF + h * 128 + c8); k8[rep] = *(const v4u*)(U + row * NINP + GK_OFF + h * 128 + c8);
          bc0[rep] = *(const f32x4*)(BCUM + row * 512 + h * 128 + c8); bc1[rep] = *(const f32x4*)(BCUM + row * 512 + h * 128 + c8 + 4); }
#pragma unroll
      for (int rep = 0; rep < 2; ++rep) { const int idx = tid + NTHR * rep, i = idx >> 4, c8 = (idx & 15) * 8;
          const float bc[8] = {bc0[rep][0], bc0[rep][1], bc0[rep][2], bc0[rep][3], bc1[rep][0], bc1[rep][1], bc1[rep][2], bc1[rep][3]};
          const unsigned qw[4] = {q8[rep].x, q8[rep].y, q8[rep].z, q8[rep].w}, kw[4] = {k8[rep].x, k8[rep].y, k8[rep].z, k8[rep].w};
          unsigned qo[4], ko[4];
#pragma unroll
          for (int e = 0; e < 4; ++e) { const float e0 = __expf(bc[2 * e]), e1 = __expf(bc[2 * e + 1]);
              qo[e] = pg8::cvt_pk_bf16(bflo(qw[e]) * 0.08838834764831845f * e0, bfhi(qw[e]) * 0.08838834764831845f * e1);
              ko[e] = pg8::cvt_pk_bf16(bflo(kw[e]) * __builtin_amdgcn_rcpf(e0), bfhi(kw[e]) * __builtin_amdgcn_rcpf(e1)); }
          *(LAS v4u*)(QD + i * QS + c8) = (v4u){qo[0], qo[1], qo[2], qo[3]}; *(LAS v4u*)(KI + i * QS + c8) = (v4u){ko[0], ko[1], ko[2], ko[3]}; } }
    load_vt(U, row0, GV_OFF + h * 256 + 32 * wave, VTw, lane);
    bf16x8_t sp[2][4];
#pragma unroll
    for (int vt = 0; vt < 2; ++vt)
#pragma unroll
        for (int ks = 0; ks < 4; ++ks) sp[vt][ks] = *(const bf16x8_t*)(SPT + (size_t)task * 32768 + (32 * wave + vt * 16 + l15) * 128 + ks * 32 + 8 * lq);
    v2u rr8[4][2];
#pragma unroll
    for (int it = 0; it < 4; ++it)
#pragma unroll
        for (int vt = 0; vt < 2; ++vt) rr8[it][vt] = *(const v2u*)(U + (row0 + it * 16 + l15) * NINP + GR_OFF + h * 256 + 32 * wave + vt * 16 + lq * 4);
    __syncthreads();
#pragma unroll
    for (int tt = 0; tt < 2; ++tt) { const int tile = 2 * wave + tt, it = tile >> 2, jt = tile & 3;
        f32x4 sv = (f32x4){0.f, 0.f, 0.f, 0.f};
        if (jt <= it) {
#pragma unroll
            for (int ks = 0; ks < 4; ++ks) { const bf16x8_t A = *(const LAS bf16x8_t*)(KI + (jt * 16 + l15) * QS + ks * 32 + 8 * lq), B = *(const LAS bf16x8_t*)(QD + (it * 16 + l15) * QS + ks * 32 + 8 * lq);
                sv = __builtin_amdgcn_mfma_f32_16x16x32_bf16(A, B, sv, 0, 0, 0); } }
        const int i = it * 16 + l15, j0 = jt * 16 + lq * 4;
#pragma unroll
        for (int r = 0; r < 4; ++r) if (j0 + r > i) sv[r] = 0.f;
        v2u pk; pk.x = pk2(sv[0], sv[1]); pk.y = pk2(sv[2], sv[3]);
        *(LAS v2u*)(ATT + i * KTS + j0) = pk; }
    __syncthreads();
    f32x4 acc[2][4];
#pragma unroll
    for (int it = 0; it < 4; ++it) { acc[0][it] = (f32x4){0.f, 0.f, 0.f, 0.f}; acc[1][it] = (f32x4){0.f, 0.f, 0.f, 0.f};
#pragma unroll
        for (int ks = 0; ks < 4; ++ks) { const bf16x8_t B = *(const LAS bf16x8_t*)(QD + (it * 16 + l15) * QS + ks * 32 + 8 * lq);
            acc[0][it] = __builtin_amdgcn_mfma_f32_16x16x32_bf16(sp[0][ks], B, acc[0][it], 0, 0, 0); acc[1][it] = __builtin_amdgcn_mfma_f32_16x16x32_bf16(sp[1][ks], B, acc[1][it], 0, 0, 0); }
#pragma unroll
        for (int ks = 0; ks < 2; ++ks) { const bf16x8_t B = *(const LAS bf16x8_t*)(ATT + (it * 16 + l15) * KTS + ks * 32 + 8 * lq);
            const bf16x8_t A0 = *(const LAS bf16x8_t*)(VTw + (l15) * KTS + ks * 32 + 8 * lq), A1 = *(const LAS bf16x8_t*)(VTw + (16 + l15) * KTS + ks * 32 + 8 * lq);
            acc[0][it] = __builtin_amdgcn_mfma_f32_16x16x32_bf16(A0, B, acc[0][it], 0, 0, 0); acc[1][it] = __builtin_amdgcn_mfma_f32_16x16x32_bf16(A1, B, acc[1][it], 0, 0, 0); } }
#pragma unroll
    for (int it = 0; it < 4; ++it) { float ssq = 0.f;
#pragma unroll
        for (int vt = 0; vt < 2; ++vt) { const f32x4 x = acc[vt][it]; ssq += (x[0] * x[0] + x[1] * x[1]) + (x[2] * x[2] + x[3] * x[3]); }
        ssq += __shfl_xor(ssq, 16); ssq += __shfl_xor(ssq, 32);
        if (lq == 0) SSQ[wave * 64 + it * 16 + l15] = ssq; }
    __syncthreads();
#pragma unroll
    for (int it = 0; it < 4; ++it) { const int i = it * 16 + l15; float tot = 0.f;
#pragma unroll
        for (int w = 0; w < 8; ++w) tot += SSQ[w * 64 + i];
        const float rinv = rsqrtf(tot * (1.0f / 256.0f) + EPS); const size_t row = row0 + i;
#pragma unroll
        for (int vt = 0; vt < 2; ++vt) { const int v = 32 * wave + vt * 16 + lq * 4;
            const v2u rr = rr8[it][vt]; const f32x4 g = *(const f32x4*)(gout + v); const f32x4 x = acc[vt][it];
            v2u pk; pk.x = pk2(x[0] * rinv * g[0] * pg8::silu_f(bflo(rr.x)), x[1] * rinv * g[1] * pg8::silu_f(bfhi(rr.x)));
            pk.y = pk2(x[2] * rinv * g[2] * pg8::silu_f(bflo(rr.y)), x[3] * rinv * g[3] * pg8::silu_f(bfhi(rr.y)));
            *(v2u*)(MIX + row * D_ + h * 256 + v) = pk; } }
    __syncthreads();
}

__global__ void __launch_bounds__(NTHR, 2) hymba_fwd(Args a) {
    extern __shared__ __attribute__((aligned(16))) unsigned char lds_raw[];
    LAS unsigned char* lds = (LAS unsigned char*)lds_raw;
    cg::grid_group grid = cg::this_grid();
    const int tid = threadIdx.x, lane = tid & 63, wave = __builtin_amdgcn_readfirstlane(tid >> 6);
    const int G = gridDim.x, gw = blockIdx.x * NWAVES + wave, NGW = G * NWAVES;
    unsigned char* ws = a.ws;
    volatile LAS unsigned* xst = (volatile LAS unsigned*)(lds + LDS_BYTES - 64);
    if (tid < 16) xst[tid] = 0u;
    __syncthreads();
    const XcdBarrier bar = xcd_barrier_post((unsigned*)ws, xst);
    unsigned* xrk = (unsigned*)ws + 3600;
    if (tid == 0) { xst[4] = bar.x; xst[5] = __hip_atomic_fetch_add(xrk + bar.x, 1u, __ATOMIC_RELAXED, __HIP_MEMORY_SCOPE_AGENT); }
    int vc = (int)blockIdx.x;
    const float* x = a.in[0]; float* out = a.out;
    bf16 *W1GU = (bf16*)(ws + WS_W1GU), *W1D = (bf16*)(ws + WS_W1D), *W2GU = (bf16*)(ws + WS_W2GU), *W2D = (bf16*)(ws + WS_W2D), *WIN = (bf16*)(ws + WS_WIN),
         *WOUT = (bf16*)(ws + WS_WOUT), *WQ = (bf16*)(ws + WS_WQ), *WKV = (bf16*)(ws + WS_WKV), *WO = (bf16*)(ws + WS_WO);
    bf16 *XN = (bf16*)(ws + WS_XN), *MEMN = (bf16*)(ws + WS_MEMN), *ACT = (bf16*)(ws + WS_ACT), *U = (bf16*)(ws + WS_ACT), *XQ = (bf16*)(ws + WS_XQ), *XO = (bf16*)(ws + WS_XO),
         *MKV = (bf16*)(ws + WS_MKV), *MIX = (bf16*)(ws + WS_MIX);
    float *SS = (float*)(ws + WS_SS), *ORAW = (float*)(ws + WS_XN), *LR = (float*)(ws + WS_LR), *LA = (float*)(ws + WS_LA), *KMEAN = (float*)(ws + WS_KMEAN);
    float *UPDT = (float*)(ws + WS_UPDT), *DEC = (float*)(ws + WS_DEC); bf16* SPT = (bf16*)(ws + WS_SPT);
#define IN(k) (a.lo1 <= (k) && (k) < a.hi1)
#define SEAM(k) do { if (a.lo1 <= (k) && (k) < a.hi1 && ((k) + 1 < a.hi1 || a.lo2 < a.hi2)) { if (a.hi2 < 0) grid.sync(); else xcd_barrier(bar); } } while (0)

    if (IN(0)) {
        LAS float* scr = (LAS float*)(lds + wave * 16384);
        convert_range(IL_W1GU, IL_W1D, gw, NGW, a, ws, scr, lane);
        if (gw >= 768) convert_range(IL_WOUT, IL_W2GU, gw - 768, NGW - 768, a, ws, scr, lane);
        const float* g1 = a.in[2];
        for (int m = gw; m < M_; m += NGW) {
            const f32x4* xr = (const f32x4*)(x + (size_t)m * D_) + lane; f32x4 v[8]; float ss = 0.f;
#pragma unroll
            for (int j = 0; j < 8; ++j) { v[j] = xr[64 * j]; ss += (v[j][0] * v[j][0] + v[j][1] * v[j][1]) + (v[j][2] * v[j][2] + v[j][3] * v[j][3]); }
            ss = wave_sum(ss);
#pragma unroll
            for (int j = 0; j < 8; ++j) { const f32x4 gv = ((const f32x4*)g1)[lane + 64 * j]; const f32x4 w = v[j] * gv; v2u pk; pk.x = pk2(w[0], w[1]); pk.y = pk2(w[2], w[3]);
                *(v2u*)(XN + (size_t)m * D_ + 4 * lane + 256 * j) = pk; }
            if (lane < 32) SS[(size_t)m * 32 + lane] = (lane == 0) ? ss : 0.f;
        }
        const float* gm = a.in[15]; const float* mem = a.in[1];
        for (int m = gw; m < MM_; m += NGW) {
            const f32x4* xr = (const f32x4*)(mem + (size_t)m * D_) + lane; f32x4 v[8]; float ss = 0.f;
#pragma unroll
            for (int j = 0; j < 8; ++j) { v[j] = xr[64 * j]; ss += (v[j][0] * v[j][0] + v[j][1] * v[j][1]) + (v[j][2] * v[j][2] + v[j][3] * v[j][3]); }
            const float rs = rsqrtf(wave_sum(ss) * (1.0f / D_) + EPS);
#pragma unroll
            for (int j = 0; j < 8; ++j) { const f32x4 gv = ((const f32x4*)gm)[lane + 64 * j]; const f32x4 w = v[j] * gv * rs; v2u pk; pk.x = pk2(w[0], w[1]); pk.y = pk2(w[2], w[3]);
                *(v2u*)(MEMN + (size_t)m * D_ + 4 * lane + 256 * j) = pk; }
        }
        __syncthreads();
    }
    SEAM(0);
    {
        bool okp = (G == 256);
        for (int j = 0; j < 16; ++j) { const unsigned cj = __hip_atomic_load(xrk + j, __ATOMIC_RELAXED, __HIP_MEMORY_SCOPE_AGENT); okp = okp && (cj == (j < 8 ? 32u : 0u)); }
        if (okp) vc = __builtin_amdgcn_readfirstlane((int)(xst[5] * 8u + xst[4]));
    }
#ifdef PROBE_SYNCS
    for (int i_ = 0; i_ < PROBE_SYNCS; ++i_) xcd_barrier(bar);
#endif
    if (IN(1)) {
        pg8::Gemm g{XN, W1GU, M_, NGU, D_}; pg8::StaticOrder S; S.init(M_, NGU, G, vc);
        pg8::EpiSwiGLU E{ACT, FF_, SS};
        pg8::gemm_phase<pg8::EpiSwiGLU, pg8::StaticOrder, true, true>(lds, g, S, E);
        if (vc >= 128) convert_range(IL_W1D, IL_WOUT, (vc - 128) * NWAVES + wave, (G - 128) * NWAVES, a, ws, (LAS float*)(lds + wave * 16384), lane);
    }
    SEAM(1);
    if (IN(2)) {
        pg8::Gemm g{ACT, W1D, M_, D_, FF_}; pg8::StaticOrder S; S.init(M_, D_, G, vc);
        pg8::EpiResid E{x, out, D_, 0.5f, XN, a.in[6], SS};
        pg8::gemm_phase<pg8::EpiResid, pg8::StaticOrder, true, true>(lds, g, S, E);
    }
    SEAM(2);
    if (IN(3)) {
        pg8::Gemm g{XN, WIN, M_, NU, D_}; pg8::StaticOrder S; S.init(M_, NU, G, vc);
        pg8::EpiScale<false> E{U, NINP, SS, nullptr};
        pg8::gemm_phase<pg8::EpiScale<false>, pg8::StaticOrder, true, true>(lds, g, S, E);
    }
    SEAM(3);
    if (IN(4)) {
        const float* w2 = a.in[8]; const float* b2 = a.in[9];
        {
            const bf16* WLR = WIN + (size_t)NU * D_; const int l15 = lane & 15, lq = lane >> 4;
            LAS float* lrp = (LAS float*)lds;
            LAS float* rsl = (LAS float*)(lds + 16384);
            for (int rb = blockIdx.x; rb < M_ / 32; rb += G) { const size_t row0 = (size_t)rb * 32;
                f32x4 la[2] = {(f32x4){0.f, 0.f, 0.f, 0.f}, (f32x4){0.f, 0.f, 0.f, 0.f}};
#pragma unroll
                for (int half = 0; half < 2; ++half) { bf16x8_t Bf[4], Af[4][2];
#pragma unroll
                    for (int kk = 0; kk < 4; ++kk) { const int ko = (wave * 8 + half * 4 + kk) * 32 + 8 * lq;
                        Bf[kk] = *(const bf16x8_t*)(WLR + (size_t)l15 * D_ + ko);
#pragma unroll
                        for (int mt = 0; mt < 2; ++mt) Af[kk][mt] = *(const bf16x8_t*)(XN + (row0 + mt * 16 + l15) * D_ + ko); }
                    asm volatile("" ::: "memory");
#pragma unroll
                    for (int kk = 0; kk < 4; ++kk)
#pragma unroll
                        for (int mt = 0; mt < 2; ++mt) la[mt] = __builtin_amdgcn_mfma_f32_16x16x32_bf16(Af[kk][mt], Bf[kk], la[mt], 0, 0, 0); }
#pragma unroll
                for (int mt = 0; mt < 2; ++mt)
#pragma unroll
                    for (int r = 0; r < 4; ++r) lrp[wave * 512 + (mt * 16 + lq * 4 + r) * 16 + l15] = la[mt][r];
                if (tid < 32) { const f32x4* sp = (const f32x4*)(SS + (row0 + tid) * 32); float t = 0.f;
#pragma unroll
                    for (int j = 0; j < 8; ++j) { const f32x4 v = sp[j]; t += (v[0] + v[1]) + (v[2] + v[3]); }
                    rsl[tid] = rsqrtf(t * (1.0f / D_) + EPS); }
                __syncthreads();
                { float t = 0.f;
#pragma unroll
                  for (int w = 0; w < 8; ++w) t += lrp[w * 512 + tid];
                  LR[row0 * 16 + tid] = t * rsl[tid >> 4]; }
                __syncthreads(); }
            xcd_barrier(bar);
        }
        if (!ANCHOR_GLA) { for (int task = blockIdx.x; task < 512; task += G) gla_a(task, U, LR, w2, b2, LA, DEC, UPDT, lds, tid); }
        if (ANCHOR_GLA) for (int idx = blockIdx.x * NTHR + tid; idx < M_ * 512; idx += G * NTHR) {
            const int row = idx >> 9, c = idx & 511; const float* lr = LR + (size_t)row * 16; float acc = b2[c];
#pragma unroll
            for (int j = 0; j < 16; ++j) acc += lr[j] * w2[j * 512 + c];
            const float ls = fminf(acc, 0.f) - log1pf(__expf(-fabsf(acc)));
            LA[idx] = ls * (1.0f / 16.0f);
        }
        const float* gq = a.in[11]; const float* gk = a.in[12];
        const int e8 = (lane & 15) * 8, sub = lane >> 4;
        f32x4 gq0 = *(const f32x4*)(gq + e8), gq1 = *(const f32x4*)(gq + e8 + 4), gk0 = *(const f32x4*)(gk + e8), gk1 = *(const f32x4*)(gk + e8 + 4);
        v4u qv[4][2];
#pragma unroll
        for (int rr = 0; rr < 4; ++rr)
#pragma unroll
            for (int j = 0; j < 2; ++j) qv[rr][j] = *(const v4u*)(U + (size_t)(gw + rr * NGW) * NINP + MQ_OFF + (sub + 4 * j) * 128 + e8);
        asm volatile("" ::: "memory");
#pragma unroll
        for (int rr = 0; rr < 4; ++rr) { const int row = gw + rr * NGW;
#pragma unroll
            for (int j = 0; j < 2; ++j) { const int hh = sub + 4 * j; bf16* p = U + (size_t)row * NINP + MQ_OFF + hh * 128 + e8;
                const v4u r = qv[rr][j]; float f[8] = {bflo(r.x), bfhi(r.x), bflo(r.y), bfhi(r.y), bflo(r.z), bfhi(r.z), bflo(r.w), bfhi(r.w)};
                float ss = 0.f;
#pragma unroll
                for (int i = 0; i < 8; ++i) ss += f[i] * f[i];
                ss += __shfl_xor(ss, 1); ss += __shfl_xor(ss, 2); ss += __shfl_xor(ss, 4); ss += __shfl_xor(ss, 8);
                const float rs = rsqrtf(ss * (1.0f / 128.0f) + EPS);
                v4u o; o.x = pk2(f[0] * rs * gq0[0], f[1] * rs * gq0[1]); o.y = pk2(f[2] * rs * gq0[2], f[3] * rs * gq0[3]); o.z = pk2(f[4] * rs * gq1[0], f[5] * rs * gq1[1]); o.w = pk2(f[6] * rs * gq1[2], f[7] * rs * gq1[3]);
                *(v4u*)p = o; }
        }
        for (int task = blockIdx.x; task < B_ * 8 * 16; task += G) {
            const int b = task >> 7, h = (task >> 4) & 7, blk = task & 15; float ms[8] = {0.f, 0.f, 0.f, 0.f, 0.f, 0.f, 0.f, 0.f};
            bf16* p0 = U + (size_t)(b * T_ + blk * 256 + 32 * wave + sub) * NINP + MK_OFF + h * 128 + e8;
            v4u rv[8];
#pragma unroll
            for (int it = 0; it < 8; ++it) rv[it] = *(const v4u*)(p0 + (size_t)(it * 4) * NINP);
            asm volatile("" ::: "memory");
#pragma unroll
            for (int it = 0; it < 8; ++it) { const v4u r = rv[it]; float f[8] = {bflo(r.x), bfhi(r.x), bflo(r.y), bfhi(r.y), bflo(r.z), bfhi(r.z), bflo(r.w), bfhi(r.w)};
                float ss = 0.f;
#pragma unroll
                for (int i = 0; i < 8; ++i) ss += f[i] * f[i];
                ss += __shfl_xor(ss, 1); ss += __shfl_xor(ss, 2); ss += __shfl_xor(ss, 4); ss += __shfl_xor(ss, 8);
                const float rs = rsqrtf(ss * (1.0f / 128.0f) + EPS);
                f[0] *= rs * gk0[0]; f[1] *= rs * gk0[1]; f[2] *= rs * gk0[2]; f[3] *= rs * gk0[3]; f[4] *= rs * gk1[0]; f[5] *= rs * gk1[1]; f[6] *= rs * gk1[2]; f[7] *= rs * gk1[3];
#pragma unroll
                for (int i = 0; i < 8; ++i) ms[i] += f[i];
                v4u o; o.x = pk2(f[0], f[1]); o.y = pk2(f[2], f[3]); o.z = pk2(f[4], f[5]); o.w = pk2(f[6], f[7]);
                *(v4u*)(p0 + (size_t)(it * 4) * NINP) = o; }
#pragma unroll
            for (int i = 0; i < 8; ++i) { ms[i] += __shfl_xor(ms[i], 16); ms[i] += __shfl_xor(ms[i], 32); }
            LAS float* part = (LAS float*)lds;
            if (sub == 0) { *(LAS f32x4*)(part + wave * 128 + e8) = (f32x4){ms[0], ms[1], ms[2], ms[3]}; *(LAS f32x4*)(part + wave * 128 + e8 + 4) = (f32x4){ms[4], ms[5], ms[6], ms[7]}; }
            __syncthreads();
            if (tid < 128) { float t = 0.f;
#pragma unroll
                for (int w = 0; w < 8; ++w) t += part[w * 128 + tid];
                KMEAN[(size_t)task * 128 + tid] = t * (1.0f / 256.0f); }
            __syncthreads();
        }
    }
    SEAM(4);
    if (IN(5)) {
        constexpr int NGLA = ANCHOR_GLA ? 16 : 0;
        if (ANCHOR_GLA && (int)blockIdx.x < NGLA) {
            const int bh = blockIdx.x >> 1, b = bh >> 2, h = bh & 3, v = (blockIdx.x & 1) * 128 + (tid >> 2), kp = tid & 3;
            float S[32];
#pragma unroll
            for (int i = 0; i < 32; ++i) S[i] = 0.f;
            for (int t = 0; t < T_; ++t) {
                const size_t row = (size_t)b * T_ + t; const bf16* ur = U + row * NINP;
                const v4u* qp = (const v4u*)(ur + GQ_OFF + h * 128 + kp * 32); const v4u* kpp = (const v4u*)(ur + GK_OFF + h * 128 + kp * 32);
                const f32x4* lap = (const f32x4*)(LA + row * 512 + h * 128 + kp * 32);
                const float vv = bflo((unsigned)ur[GV_OFF + h * 256 + v]);
                float o = 0.f;
#pragma unroll
                for (int i4 = 0; i4 < 4; ++i4) { const v4u qq = qp[i4], kk = kpp[i4]; const f32x4 la0 = lap[2 * i4], la1 = lap[2 * i4 + 1];
                    const float qf[8] = {bflo(qq.x), bfhi(qq.x), bflo(qq.y), bfhi(qq.y), bflo(qq.z), bfhi(qq.z), bflo(qq.w), bfhi(qq.w)};
                    const float kf[8] = {bflo(kk.x), bfhi(kk.x), bflo(kk.y), bfhi(kk.y), bflo(kk.z), bfhi(kk.z), bflo(kk.w), bfhi(kk.w)};
                    const float lf[8] = {la0[0], la0[1], la0[2], la0[3], la1[0], la1[1], la1[2], la1[3]};
#pragma unroll
                    for (int e = 0; e < 8; ++e) { const int i = i4 * 8 + e; S[i] = __expf(lf[e]) * S[i] + kf[e] * vv; o += qf[e] * S[i]; } }
                o *= 0.08838834764831845f;
                o += __shfl_xor(o, 1); o += __shfl_xor(o, 2);
                if (kp == 0) ORAW[row * 1024 + h * 256 + v] = o;
            }
        } else if (!ANCHOR_MOBA) {
            const int p = (int)blockIdx.x - NGLA, pp = p & 127;
            const int bh = pp >> 3, xx = pp & 7, b = bh >> 3, h = bh & 7;
            if (!ANCHOR_GLA && p >= 128 && p < 256) { gla_scan((p - 128) * NTHR + tid, UPDT, DEC, SPT);
                convert_range(IL_W2GU, IL_W2D, (p - 128) * NWAVES + wave, 128 * NWAVES, a, ws, (LAS float*)(lds + wave * 16384), lane); __syncthreads(); }
            if (p < 256) { const bf16* kb = U + (size_t)(b * T_) * NINP + h * 128;
                const int qb = p < 128 ? 15 - xx : xx; const size_t row0 = (size_t)b * T_ + qb * 256;
                att::attn_body<NINP, NINP, D_, 1, 2, (MV_OFF - MK_OFF) * 2, false, true>(U + row0 * NINP + MQ_OFF + h * 128, kb + MK_OFF, MIX + row0 * D_ + 1024 + h * 128, 256 * (qb + 1), (char*)lds_raw,
                                                  nullptr, nullptr, KMEAN + (size_t)(bh * 16) * 128, qb); }
        } else {
            const int nw = (G - NGLA) * NWAVES, w0 = ((int)blockIdx.x - NGLA) * NWAVES + wave;
            LAS float* sc = (LAS float*)(lds + wave * 1024);
            for (int task = w0; task < M_ * 8; task += nw) {
                const int row = task >> 3, h = task & 7, b = row >> 12, t = row & 4095, qblk = t >> 8;
                const unsigned qq = *(const unsigned*)(U + (size_t)row * NINP + MQ_OFF + h * 128 + 2 * lane);
                const float q0 = bflo(qq) * 0.08838834764831845f, q1 = bfhi(qq) * 0.08838834764831845f;
                const float* km = KMEAN + ((size_t)(b * 8 + h) * 16) * 128 + 2 * lane;
                float gt[16];
#pragma unroll
                for (int n = 0; n < 16; ++n) { const f32x2 kv = *(const f32x2*)(km + n * 128); const float d = wave_sum(q0 * kv[0] + q1 * kv[1]); gt[n] = (n < qblk) ? d : -3e38f; }
                unsigned sel = 0;
#pragma unroll
                for (int r = 0; r < 3; ++r) { float best = -3e38f; int bi = -1;
#pragma unroll
                    for (int n = 0; n < 16; ++n) if (gt[n] > best) { best = gt[n]; bi = n; }
                    if (bi >= 0) { sel |= 1u << bi;
#pragma unroll
                        for (int n = 0; n < 16; ++n) if (n == bi) gt[n] = -3e38f; } }
                sel = __builtin_amdgcn_readfirstlane(sel);
                float m = -1e30f, l = 0.f, o0 = 0.f, o1 = 0.f;
                for (int n = 0; n < qblk; ++n) if ((sel >> n) & 1u) { const bf16* kb = U + (size_t)(b * T_ + n * 256) * NINP + h * 128;
                    attn_block<false>(kb + MK_OFF, kb + MV_OFF, NINP, 256, q0, q1, m, l, o0, o1, sc, lane); }
                { const bf16* kb = U + (size_t)(b * T_ + qblk * 256) * NINP + h * 128;
                    attn_block<false>(kb + MK_OFF, kb + MV_OFF, NINP, (t & 255) + 1, q0, q1, m, l, o0, o1, sc, lane); }
                const float il = 1.0f / l;
                *(unsigned*)(MIX + (size_t)row * D_ + 1024 + h * 128 + 2 * lane) = pk2(o0 * il, o1 * il);
            }
        }
    }
    SEAM(5);
    if (IN(6) && !ANCHOR_GLA) { for (int task = blockIdx.x; task < 512; task += G) gla_c(task, U, LA, SPT, a.in[10], MIX, lds, tid); }
    if (IN(6) && ANCHOR_GLA) {
        const float* go = a.in[10]; const f32x4 gv = *(const f32x4*)(go + 4 * lane);
        for (int task = gw; task < M_ * 4; task += NGW) {
            const int row = task >> 2, h = task & 3;
            const f32x4 o = *(const f32x4*)(ORAW + (size_t)row * 1024 + h * 256 + 4 * lane);
            const float ss = wave_sum((o[0] * o[0] + o[1] * o[1]) + (o[2] * o[2] + o[3] * o[3]));
            const float rs = rsqrtf(ss * (1.0f / 256.0f) + EPS);
            const v2u rr = *(const v2u*)(U + (size_t)row * NINP + GR_OFF + h * 256 + 4 * lane);
            const float r0 = bflo(rr.x), r1 = bfhi(rr.x), r2 = bflo(rr.y), r3 = bfhi(rr.y);
            v2u pk; pk.x = pk2(o[0] * rs * gv[0] * pg8::silu_f(r0), o[1] * rs * gv[1] * pg8::silu_f(r1)); pk.y = pk2(o[2] * rs * gv[2] * pg8::silu_f(r2), o[3] * rs * gv[3] * pg8::silu_f(r3));
            *(v2u*)(MIX + (size_t)row * D_ + h * 256 + 4 * lane) = pk;
        }
    }
    SEAM(6);
    if (IN(7)) {
        pg8::Gemm g{MIX, WOUT, M_, D_, D_}; pg8::StaticOrder S; S.init(M_, D_, G, vc);
        pg8::EpiResid E{out, out, D_, 1.0f, XN, a.in[14], SS};
        pg8::gemm_phase<pg8::EpiResid, pg8::StaticOrder, true, true>(lds, g, S, E);
    }
    SEAM(7);
    if (IN(8)) {
        { pg8::Gemm g{XN, WQ, M_, 512, D_}; pg8::StaticOrder S; S.init(M_, 512, G, vc);
          pg8::EpiScale<false> E{XQ, 512, SS, nullptr};
          pg8::gemm_phase<pg8::EpiScale<false>, pg8::StaticOrder, true, true>(lds, g, S, E); }
        { pg8::Gemm g{MEMN, WKV, MM_, 1024, D_}; pg8::StaticOrder S; S.init(MM_, 1024, G, (G - 1) - vc);
          pg8::EpiScale<false> E{MKV, 1024, nullptr, nullptr};
          pg8::gemm_phase<pg8::EpiScale<false>, pg8::StaticOrder, true, true>(lds, g, S, E); }
        if (vc >= 64 && vc < 248) convert_range(IL_W2D, IL_END, (vc - 64) * NWAVES + wave, 184 * NWAVES, a, ws, (LAS float*)(lds + wave * 16384), lane);
    }
    SEAM(8);
    if (IN(9) && !ANCHOR_XATTN) {
        for (int task = blockIdx.x; task < 128; task += G) { const int b = task >> 6, h = (task >> 4) & 3, qt = task & 15; const size_t row0 = (size_t)b * T_ + qt * 256;
            const bf16* kb = MKV + (size_t)(b * MEML) * 1024 + h * 128;
            att::attn_body<512, 1024, 512, 0, 2, 1024, true, false>(XQ + row0 * 512 + h * 128, kb, XO + row0 * 512 + h * 128, MEML, (char*)lds_raw, a.in[19], a.in[20], nullptr, 0); }
    }
    if (IN(9) && ANCHOR_XATTN) {
        const float* gq = a.in[19]; const float* gk = a.in[20];
        const float gg0 = gq[2 * lane] * gk[2 * lane] * 0.08838834764831845f, gg1 = gq[2 * lane + 1] * gk[2 * lane + 1] * 0.08838834764831845f;
        LAS float* sc = (LAS float*)(lds + wave * 1024);
        for (int task = gw; task < M_ * 4; task += NGW) {
            const int row = task >> 2, h = task & 3, b = row >> 12;
            const unsigned qq = *(const unsigned*)(XQ + (size_t)row * 512 + h * 128 + 2 * lane);
            float q0 = bflo(qq), q1 = bfhi(qq);
            const float rs = rsqrtf(wave_sum(q0 * q0 + q1 * q1) * (1.0f / 128.0f) + EPS);
            q0 *= rs * gg0; q1 *= rs * gg1;
            float m = -1e30f, l = 0.f, o0 = 0.f, o1 = 0.f;
            const bf16* kb = MKV + (size_t)(b * MEML) * 1024 + h * 128;
            attn_block<true>(kb, kb + 512, 1024, MEML, q0, q1, m, l, o0, o1, sc, lane);
            const float il = 1.0f / l;
            *(unsigned*)(XO + (size_t)row * 512 + h * 128 + 2 * lane) = pk2(o0 * il, o1 * il);
        }
    }
    SEAM(9);
    if (IN(10)) {
        pg8::Gemm g{XO, WO, M_, D_, 512}; pg8::StaticOrder S; S.init(M_, D_, G, vc);
        pg8::EpiResid E{out, out, D_, 1.0f, XN, a.in[21], SS};
        pg8::gemm_phase<pg8::EpiResid, pg8::StaticOrder, true, true>(lds, g, S, E);
    }
    SEAM(10);
    if (IN(11)) {
        pg8::Gemm g{XN, W2GU, M_, NGU, D_}; pg8::StaticOrder S; S.init(M_, NGU, G, vc);
        pg8::EpiSwiGLU E{ACT, FF_, SS};
        pg8::gemm_phase<pg8::EpiSwiGLU, pg8::StaticOrder, true, true>(lds, g, S, E);
    }
    SEAM(11);
    if (IN(12)) {
        pg8::Gemm g{ACT, W2D, M_, D_, FF_}; pg8::StaticOrder S; S.init(M_, D_, G, vc);
        pg8::EpiResid E{out, out, D_, 0.5f, nullptr, nullptr, nullptr};
        pg8::gemm_phase<pg8::EpiResid, pg8::StaticOrder, true, true>(lds, g, S, E);
    }
#undef IN
#undef SEAM
#ifdef PROBE_REP
#define IN(k) (a.lo2 <= (k) && (k) < a.hi2)
#define SEAM(k) do { if (a.lo2 <= (k) && (k) + 1 < a.hi2) xcd_barrier(bar); } while (0)

    if (IN(0)) {
        LAS float* scr = (LAS float*)(lds + wave * 16384);
        convert_range(IL_W1GU, IL_W1D, gw, NGW, a, ws, scr, lane);
        if (gw >= 768) convert_range(IL_WOUT, IL_W2GU, gw - 768, NGW - 768, a, ws, scr, lane);
        const float* g1 = a.in[2];
        for (int m = gw; m < M_; m += NGW) {
            const f32x4* xr = (const f32x4*)(x + (size_t)m * D_) + lane; f32x4 v[8]; float ss = 0.f;
#pragma unroll
            for (int j = 0; j < 8; ++j) { v[j] = xr[64 * j]; ss += (v[j][0] * v[j][0] + v[j][1] * v[j][1]) + (v[j][2] * v[j][2] + v[j][3] * v[j][3]); }
            ss = wave_sum(ss);
#pragma unroll
            for (int j = 0; j < 8; ++j) { const f32x4 gv = ((const f32x4*)g1)[lane + 64 * j]; const f32x4 w = v[j] * gv; v2u pk; pk.x = pk2(w[0], w[1]); pk.y = pk2(w[2], w[3]);
                *(v2u*)(XN + (size_t)m * D_ + 4 * lane + 256 * j) = pk; }
            if (lane < 32) SS[(size_t)m * 32 + lane] = (lane == 0) ? ss : 0.f;
        }
        const float* gm = a.in[15]; const float* mem = a.in[1];
        for (int m = gw; m < MM_; m += NGW) {
            const f32x4* xr = (const f32x4*)(mem + (size_t)m * D_) + lane; f32x4 v[8]; float ss = 0.f;
#pragma unroll
            for (int j = 0; j < 8; ++j) { v[j] = xr[64 * j]; ss += (v[j][0] * v[j][0] + v[j][1] * v[j][1]) + (v[j][2] * v[j][2] + v[j][3] * v[j][3]); }
            const float rs = rsqrtf(wave_sum(ss) * (1.0f / D_) + EPS);
#pragma unroll
            for (int j = 0; j < 8; ++j) { const f32x4 gv = ((const f32x4*)gm)[lane + 64 * j]; const f32x4 w = v[j] * gv * rs; v2u pk; pk.x = pk2(w[0], w[1]); pk.y = pk2(w[2], w[3]);
                *(v2u*)(MEMN + (size_t)m * D_ + 4 * lane + 256 * j) = pk; }
        }
        __syncthreads();
    }
    SEAM(0);
    {
        bool okp = (G == 256);
        for (int j = 0; j < 16; ++j) { const unsigned cj = __hip_atomic_load(xrk + j, __ATOMIC_RELAXED, __HIP_MEMORY_SCOPE_AGENT); okp = okp && (cj == (j < 8 ? 32u : 0u)); }
        if (okp) vc = __builtin_amdgcn_readfirstlane((int)(xst[5] * 8u + xst[4]));
    }
#ifdef PROBE_SYNCS
    for (int i_ = 0; i_ < PROBE_SYNCS; ++i_) xcd_barrier(bar);
#endif
    if (IN(1)) {
        pg8::Gemm g{XN, W1GU, M_, NGU, D_}; pg8::StaticOrder S; S.init(M_, NGU, G, vc);
        pg8::EpiSwiGLU E{ACT, FF_, SS};
        pg8::gemm_phase<pg8::EpiSwiGLU, pg8::StaticOrder, true, true>(lds, g, S, E);
        if (vc >= 128) convert_range(IL_W1D, IL_WOUT, (vc - 128) * NWAVES + wave, (G - 128) * NWAVES, a, ws, (LAS float*)(lds + wave * 16384), lane);
    }
    SEAM(1);
    if (IN(2)) {
        pg8::Gemm g{ACT, W1D, M_, D_, FF_}; pg8::StaticOrder S; S.init(M_, D_, G, vc);
        pg8::EpiResid E{x, out, D_, 0.5f, XN, a.in[6], SS};
        pg8::gemm_phase<pg8::EpiResid, pg8::StaticOrder, true, true>(lds, g, S, E);
    }
    SEAM(2);
    if (IN(3)) {
        pg8::Gemm g{XN, WIN, M_, NU, D_}; pg8::StaticOrder S; S.init(M_, NU, G, vc);
        pg8::EpiScale<false> E{U, NINP, SS, nullptr};
        pg8::gemm_phase<pg8::EpiScale<false>, pg8::StaticOrder, true, true>(lds, g, S, E);
    }
    SEAM(3);
    if (IN(4)) {
        const float* w2 = a.in[8]; const float* b2 = a.in[9];
        {
            const bf16* WLR = WIN + (size_t)NU * D_; const int l15 = lane & 15, lq = lane >> 4;
            LAS float* lrp = (LAS float*)lds;
            LAS float* rsl = (LAS float*)(lds + 16384);
            for (int rb = blockIdx.x; rb < M_ / 32; rb += G) { const size_t row0 = (size_t)rb * 32;
                f32x4 la[2] = {(f32x4){0.f, 0.f, 0.f, 0.f}, (f32x4){0.f, 0.f, 0.f, 0.f}};
#pragma unroll
                for (int half = 0; half < 2; ++half) { bf16x8_t Bf[4], Af[4][2];
#pragma unroll
                    for (int kk = 0; kk < 4; ++kk) { const int ko = (wave * 8 + half * 4 + kk) * 32 + 8 * lq;
                        Bf[kk] = *(const bf16x8_t*)(WLR + (size_t)l15 * D_ + ko);
#pragma unroll
                        for (int mt = 0; mt < 2; ++mt) Af[kk][mt] = *(const bf16x8_t*)(XN + (row0 + mt * 16 + l15) * D_ + ko); }
                    asm volatile("" ::: "memory");
#pragma unroll
                    for (int kk = 0; kk < 4; ++kk)
#pragma unroll
                        for (int mt = 0; mt < 2; ++mt) la[mt] = __builtin_amdgcn_mfma_f32_16x16x32_bf16(Af[kk][mt], Bf[kk], la[mt], 0, 0, 0); }
#pragma unroll
                for (int mt = 0; mt < 2; ++mt)
#pragma unroll
                    for (int r = 0; r < 4; ++r) lrp[wave * 512 + (mt * 16 + lq * 4 + r) * 16 + l15] = la[mt][r];
                if (tid < 32) { const f32x4* sp = (const f32x4*)(SS + (row0 + tid) * 32); float t = 0.f;
#pragma unroll
                    for (int j = 0; j < 8; ++j) { const f32x4 v = sp[j]; t += (v[0] + v[1]) + (v[2] + v[3]); }
                    rsl[tid] = rsqrtf(t * (1.0f / D_) + EPS); }
                __syncthreads();
                { float t = 0.f;
#pragma unroll
                  for (int w = 0; w < 8; ++w) t += lrp[w * 512 + tid];
                  LR[row0 * 16 + tid] = t * rsl[tid >> 4]; }
                __syncthreads(); }
            xcd_barrier(bar);
        }
        if (!ANCHOR_GLA) { for (int task = blockIdx.x; task < 512; task += G) gla_a(task, U, LR, w2, b2, LA, DEC, UPDT, lds, tid); }
        if (ANCHOR_GLA) for (int idx = blockIdx.x * NTHR + tid; idx < M_ * 512; idx += G * NTHR) {
            const int row = idx >> 9, c = idx & 511; const float* lr = LR + (size_t)row * 16; float acc = b2[c];
#pragma unroll
            for (int j = 0; j < 16; ++j) acc += lr[j] * w2[j * 512 + c];
            const float ls = fminf(acc, 0.f) - log1pf(__expf(-fabsf(acc)));
            LA[idx] = ls * (1.0f / 16.0f);
        }
        const float* gq = a.in[11]; const float* gk = a.in[12];
        const int e8 = (lane & 15) * 8, sub = lane >> 4;
        f32x4 gq0 = *(const f32x4*)(gq + e8), gq1 = *(const f32x4*)(gq + e8 + 4), gk0 = *(const f32x4*)(gk + e8), gk1 = *(const f32x4*)(gk + e8 + 4);
        v4u qv[4][2];
#pragma unroll
        for (int rr = 0; rr < 4; ++rr)
#pragma unroll
            for (int j = 0; j < 2; ++j) qv[rr][j] = *(const v4u*)(U + (size_t)(gw + rr * NGW) * NINP + MQ_OFF + (sub + 4 * j) * 128 + e8);
        asm volatile("" ::: "memory");
#pragma unroll
        for (int rr = 0; rr < 4; ++rr) { const int row = gw + rr * NGW;
#pragma unroll
            for (int j = 0; j < 2; ++j) { const int hh = sub + 4 * j; bf16* p = U + (size_t)row * NINP + MQ_OFF + hh * 128 + e8;
                const v4u r = qv[rr][j]; float f[8] = {bflo(r.x), bfhi(r.x), bflo(r.y), bfhi(r.y), bflo(r.z), bfhi(r.z), bflo(r.w), bfhi(r.w)};
                float ss = 0.f;
#pragma unroll
                for (int i = 0; i < 8; ++i) ss += f[i] * f[i];
                ss += __shfl_xor(ss, 1); ss += __shfl_xor(ss, 2); ss += __shfl_xor(ss, 4); ss += __shfl_xor(ss, 8);
                const float rs = rsqrtf(ss * (1.0f / 128.0f) + EPS);
                v4u o; o.x = pk2(f[0] * rs * gq0[0], f[1] * rs * gq0[1]); o.y = pk2(f[2] * rs * gq0[2], f[3] * rs * gq0[3]); o.z = pk2(f[4] * rs * gq1[0], f[5] * rs * gq1[1]); o.w = pk2(f[6] * rs * gq1[2], f[7] * rs * gq1[3]);
                *(v4u*)p = o; }
        }
        for (int task = blockIdx.x; task < B_ * 8 * 16; task += G) {
            const int b = task >> 7, h = (task >> 4) & 7, blk = task & 15; float ms[8] = {0.f, 0.f, 0.f, 0.f, 0.f, 0.f, 0.f, 0.f};
            bf16* p0 = U + (size_t)(b * T_ + blk * 256 + 32 * wave + sub) * NINP + MK_OFF + h * 128 + e8;
            v4u rv[8];
#pragma unroll
            for (int it = 0; it < 8; ++it) rv[it] = *(const v4u*)(p0 + (size_t)(it * 4) * NINP);
            asm volatile("" ::: "memory");
#pragma unroll
            for (int it = 0; it < 8; ++it) { const v4u r = rv[it]; float f[8] = {bflo(r.x), bfhi(r.x), bflo(r.y), bfhi(r.y), bflo(r.z), bfhi(r.z), bflo(r.w), bfhi(r.w)};
                float ss = 0.f;
#pragma unroll
                for (int i = 0; i < 8; ++i) ss += f[i] * f[i];
                ss += __shfl_xor(ss, 1); ss += __shfl_xor(ss, 2); ss += __shfl_xor(ss, 4); ss += __shfl_xor(ss, 8);
                const float rs = rsqrtf(ss * (1.0f / 128.0f) + EPS);
                f[0] *= rs * gk0[0]; f[1] *= rs * gk0[1]; f[2] *= rs * gk0[2]; f[3] *= rs * gk0[3]; f[4] *= rs * gk1[0]; f[5] *= rs * gk1[1]; f[6] *= rs * gk1[2]; f[7] *= rs * gk1[3];
#pragma unroll
                for (int i = 0; i < 8; ++i) ms[i] += f[i];
                v4u o; o.x = pk2(f[0], f[1]); o.y = pk2(f[2], f[3]); o.z = pk2(f[4], f[5]); o.w = pk2(f[6], f[7]);
                *(v4u*)(p0 + (size_t)(it * 4) * NINP) = o; }
#pragma unroll
            for (int i = 0; i < 8; ++i) { ms[i] += __shfl_xor(ms[i], 16); ms[i] += __shfl_xor(ms[i], 32); }
            LAS float* part = (LAS float*)lds;
            if (sub == 0) { *(LAS f32x4*)(part + wave * 128 + e8) = (f32x4){ms[0], ms[1], ms[2], ms[3]}; *(LAS f32x4*)(part + wave * 128 + e8 + 4) = (f32x4){ms[4], ms[5], ms[6], ms[7]}; }
            __syncthreads();
            if (tid < 128) { float t = 0.f;
#pragma unroll
                for (int w = 0; w < 8; ++w) t += part[w * 128 + tid];
                KMEAN[(size_t)task * 128 + tid] = t * (1.0f / 256.0f); }
            __syncthreads();
        }
    }
    SEAM(4);
    if (IN(5)) {
        constexpr int NGLA = ANCHOR_GLA ? 16 : 0;
        if (ANCHOR_GLA && (int)blockIdx.x < NGLA) {
            const int bh = blockIdx.x >> 1, b = bh >> 2, h = bh & 3, v = (blockIdx.x & 1) * 128 + (tid >> 2), kp = tid & 3;
            float S[32];
#pragma unroll
            for (int i = 0; i < 32; ++i) S[i] = 0.f;
            for (int t = 0; t < T_; ++t) {
                const size_t row = (size_t)b * T_ + t; const bf16* ur = U + row * NINP;
                const v4u* qp = (const v4u*)(ur + GQ_OFF + h * 128 + kp * 32); const v4u* kpp = (const v4u*)(ur + GK_OFF + h * 128 + kp * 32);
                const f32x4* lap = (const f32x4*)(LA + row * 512 + h * 128 + kp * 32);
                const float vv = bflo((unsigned)ur[GV_OFF + h * 256 + v]);
                float o = 0.f;
#pragma unroll
                for (int i4 = 0; i4 < 4; ++i4) { const v4u qq = qp[i4], kk = kpp[i4]; const f32x4 la0 = lap[2 * i4], la1 = lap[2 * i4 + 1];
                    const float qf[8] = {bflo(qq.x), bfhi(qq.x), bflo(qq.y), bfhi(qq.y), bflo(qq.z), bfhi(qq.z), bflo(qq.w), bfhi(qq.w)};
                    const float kf[8] = {bflo(kk.x), bfhi(kk.x), bflo(kk.y), bfhi(kk.y), bflo(kk.z), bfhi(kk.z), bflo(kk.w), bfhi(kk.w)};
                    const float lf[8] = {la0[0], la0[1], la0[2], la0[3], la1[0], la1[1], la1[2], la1[3]};
#pragma unroll
                    for (int e = 0; e < 8; ++e) { const int i = i4 * 8 + e; S[i] = __expf(lf[e]) * S[i] + kf[e] * vv; o += qf[e] * S[i]; } }
                o *= 0.08838834764831845f;
                o += __shfl_xor(o, 1); o += __shfl_xor(o, 2);
                if (kp == 0) ORAW[row * 1024 + h * 256 + v] = o;
            }
        } else if (!ANCHOR_MOBA) {
            const int p = (int)blockIdx.x - NGLA, pp = p & 127;
            const int bh = pp >> 3, xx = pp & 7, b = bh >> 3, h = bh & 7;
            if (!ANCHOR_GLA && p >= 128 && p < 256) { gla_scan((p - 128) * NTHR + tid, UPDT, DEC, SPT);
                convert_range(IL_W2GU, IL_W2D, (p - 128) * NWAVES + wave, 128 * NWAVES, a, ws, (LAS float*)(lds + wave * 16384), lane); __syncthreads(); }
            if (p < 256) { const bf16* kb = U + (size_t)(b * T_) * NINP + h * 128;
                const int qb = p < 128 ? 15 - xx : xx; const size_t row0 = (size_t)b * T_ + qb * 256;
                att::attn_body<NINP, NINP, D_, 1, 2, (MV_OFF - MK_OFF) * 2, false, true>(U + row0 * NINP + MQ_OFF + h * 128, kb + MK_OFF, MIX + row0 * D_ + 1024 + h * 128, 256 * (qb + 1), (char*)lds_raw,
                                                  nullptr, nullptr, KMEAN + (size_t)(bh * 16) * 128, qb); }
        } else {
            const int nw = (G - NGLA) * NWAVES, w0 = ((int)blockIdx.x - NGLA) * NWAVES + wave;
            LAS float* sc = (LAS float*)(lds + wave * 1024);
            for (int task = w0; task < M_ * 8; task += nw) {
                const int row = task >> 3, h = task & 7, b = row >> 12, t = row & 4095, qblk = t >> 8;
                const unsigned qq = *(const unsigned*)(U + (size_t)row * NINP + MQ_OFF + h * 128 + 2 * lane);
                const float q0 = bflo(qq) * 0.08838834764831845f, q1 = bfhi(qq) * 0.08838834764831845f;
                const float* km = KMEAN + ((size_t)(b * 8 + h) * 16) * 128 + 2 * lane;
                float gt[16];
#pragma unroll
                for (int n = 0; n < 16; ++n) { const f32x2 kv = *(const f32x2*)(km + n * 128); const float d = wave_sum(q0 * kv[0] + q1 * kv[1]); gt[n] = (n < qblk) ? d : -3e38f; }
                unsigned sel = 0;
#pragma unroll
                for (int r = 0; r < 3; ++r) { float best = -3e38f; int bi = -1;
#pragma unroll
                    for (int n = 0; n < 16; ++n) if (gt[n] > best) { best = gt[n]; bi = n; }
                    if (bi >= 0) { sel |= 1u << bi;
#pragma unroll
                        for (int n = 0; n < 16; ++n) if (n == bi) gt[n] = -3e38f; } }
                sel = __builtin_amdgcn_readfirstlane(sel);
                float m = -1e30f, l = 0.f, o0 = 0.f, o1 = 0.f;
                for (int n = 0; n < qblk; ++n) if ((sel >> n) & 1u) { const bf16* kb = U + (size_t)(b * T_ + n * 256) * NINP + h * 128;
                    attn_block<false>(kb + MK_OFF, kb + MV_OFF, NINP, 256, q0, q1, m, l, o0, o1, sc, lane); }
                { const bf16* kb = U + (size_t)(b * T_ + qblk * 256) * NINP + h * 128;
                    attn_block<false>(kb + MK_OFF, kb + MV_OFF, NINP, (t & 255) + 1, q0, q1, m, l, o0, o1, sc, lane); }
                const float il = 1.0f / l;
                *(unsigned*)(MIX + (size_t)row * D_ + 1024 + h * 128 + 2 * lane) = pk2(o0 * il, o1 * il);
            }
        }
    }
    SEAM(5);
    if (IN(6) && !ANCHOR_GLA) { for (int task = blockIdx.x; task < 512; task += G) gla_c(task, U, LA, SPT, a.in[10], MIX, lds, tid); }
    if (IN(6) && ANCHOR_GLA) {
        const float* go = a.in[10]; const f32x4 gv = *(const f32x4*)(go + 4 * lane);
        for (int task = gw; task < M_ * 4; task += NGW) {
            const int row = task >> 2, h = task & 3;
            const f32x4 o = *(const f32x4*)(ORAW + (size_t)row * 1024 + h * 256 + 4 * lane);
            const float ss = wave_sum((o[0] * o[0] + o[1] * o[1]) + (o[2] * o[2] + o[3] * o[3]));
            const float rs = rsqrtf(ss * (1.0f / 256.0f) + EPS);
            const v2u rr = *(const v2u*)(U + (size_t)row * NINP + GR_OFF + h * 256 + 4 * lane);
            const float r0 = bflo(rr.x), r1 = bfhi(rr.x), r2 = bflo(rr.y), r3 = bfhi(rr.y);
            v2u pk; pk.x = pk2(o[0] * rs * gv[0] * pg8::silu_f(r0), o[1] * rs * gv[1] * pg8::silu_f(r1)); pk.y = pk2(o[2] * rs * gv[2] * pg8::silu_f(r2), o[3] * rs * gv[3] * pg8::silu_f(r3));
            *(v2u*)(MIX + (size_t)row * D_ + h * 256 + 4 * lane) = pk;
        }
    }
    SEAM(6);
    if (IN(7)) {
        pg8::Gemm g{MIX, WOUT, M_, D_, D_}; pg8::StaticOrder S; S.init(M_, D_, G, vc);
        pg8::EpiResid E{out, out, D_, 1.0f, XN, a.in[14], SS};
        pg8::gemm_phase<pg8::EpiResid, pg8::StaticOrder, true, true>(lds, g, S, E);
    }
    SEAM(7);
    if (IN(8)) {
        { pg8::Gemm g{XN, WQ, M_, 512, D_}; pg8::StaticOrder S; S.init(M_, 512, G, vc);
          pg8::EpiScale<false> E{XQ, 512, SS, nullptr};
          pg8::gemm_phase<pg8::EpiScale<false>, pg8::StaticOrder, true, true>(lds, g, S, E); }
        { pg8::Gemm g{MEMN, WKV, MM_, 1024, D_}; pg8::StaticOrder S; S.init(MM_, 1024, G, (G - 1) - vc);
          pg8::EpiScale<false> E{MKV, 1024, nullptr, nullptr};
          pg8::gemm_phase<pg8::EpiScale<false>, pg8::StaticOrder, true, true>(lds, g, S, E); }
        if (vc >= 64 && vc < 248) convert_range(IL_W2D, IL_END, (vc - 64) * NWAVES + wave, 184 * NWAVES, a, ws, (LAS float*)(lds + wave * 16384), lane);
    }
    SEAM(8);
    if (IN(9) && !ANCHOR_XATTN) {
        for (int task = blockIdx.x; task < 128; task += G) { const int b = task >> 6, h = (task >> 4) & 3, qt = task & 15; const size_t row0 = (size_t)b * T_ + qt * 256;
            const bf16* kb = MKV + (size_t)(b * MEML) * 1024 + h * 128;
            att::attn_body<512, 1024, 512, 0, 2, 1024, true, false>(XQ + row0 * 512 + h * 128, kb, XO + row0 * 512 + h * 128, MEML, (char*)lds_raw, a.in[19], a.in[20], nullptr, 0); }
    }
    if (IN(9) && ANCHOR_XATTN) {
        const float* gq = a.in[19]; const float* gk = a.in[20];
        const float gg0 = gq[2 * lane] * gk[2 * lane] * 0.08838834764831845f, gg1 = gq[2 * lane + 1] * gk[2 * lane + 1] * 0.08838834764831845f;
        LAS float* sc = (LAS float*)(lds + wave * 1024);
        for (int task = gw; task < M_ * 4; task += NGW) {
            const int row = task >> 2, h = task & 3, b = row >> 12;
            const unsigned qq = *(const unsigned*)(XQ + (size_t)row * 512 + h * 128 + 2 * lane);
            float q0 = bflo(qq), q1 = bfhi(qq);
            const float rs = rsqrtf(wave_sum(q0 * q0 + q1 * q1) * (1.0f / 128.0f) + EPS);
            q0 *= rs * gg0; q1 *= rs * gg1;
            float m = -1e30f, l = 0.f, o0 = 0.f, o1 = 0.f;
            const bf16* kb = MKV + (size_t)(b * MEML) * 1024 + h * 128;
            attn_block<true>(kb, kb + 512, 1024, MEML, q0, q1, m, l, o0, o1, sc, lane);
            const float il = 1.0f / l;
            *(unsigned*)(XO + (size_t)row * 512 + h * 128 + 2 * lane) = pk2(o0 * il, o1 * il);
        }
    }
    SEAM(9);
    if (IN(10)) {
        pg8::Gemm g{XO, WO, M_, D_, 512}; pg8::StaticOrder S; S.init(M_, D_, G, vc);
        pg8::EpiResid E{out, out, D_, 1.0f, XN, a.in[21], SS};
        pg8::gemm_phase<pg8::EpiResid, pg8::StaticOrder, true, true>(lds, g, S, E);
    }
    SEAM(10);
    if (IN(11)) {
        pg8::Gemm g{XN, W2GU, M_, NGU, D_}; pg8::StaticOrder S; S.init(M_, NGU, G, vc);
        pg8::EpiSwiGLU E{ACT, FF_, SS};
        pg8::gemm_phase<pg8::EpiSwiGLU, pg8::StaticOrder, true, true>(lds, g, S, E);
    }
    SEAM(11);
    if (IN(12)) {
        pg8::Gemm g{ACT, W2D, M_, D_, FF_}; pg8::StaticOrder S; S.init(M_, D_, G, vc);
        pg8::EpiResid E{out, out, D_, 0.5f, nullptr, nullptr, nullptr};
        pg8::gemm_phase<pg8::EpiResid, pg8::StaticOrder, true, true>(lds, g, S, E);
    }
#undef IN
#undef SEAM
#endif
}

extern "C" void kernel_launch(void* const* d_in, const int* in_sizes, int n_in, void* d_out, int out_size, void* d_ws, size_t ws_size, hipStream_t stream) {
    static int grid = 0;
    if (grid == 0) {
        if (n_in != 25 || in_sizes[0] != M_ * D_ || out_size != M_ * D_ || ws_size < WS_END) { fprintf(stderr, "kernel_launch: unexpected shapes (n_in %d, in0 %d, out %d, ws %zu < %zu); nothing launched\n", n_in, n_in > 0 ? in_sizes[0] : -1, out_size, ws_size, (size_t)WS_END); grid = -1; return; }
        int dev = 0, cus = 0, per_cu = 0;
        if (hipGetDevice(&dev) != hipSuccess || hipDeviceGetAttribute(&cus, hipDeviceAttributeMultiprocessorCount, dev) != hipSuccess) { fprintf(stderr, "kernel_launch: device query failed\n"); grid = -1; return; }
        if (hipFuncSetAttribute((const void*)hymba_fwd, hipFuncAttributeMaxDynamicSharedMemorySize, LDS_BYTES) != hipSuccess) { fprintf(stderr, "kernel_launch: hipFuncSetAttribute failed\n"); grid = -1; return; }
        if (hipOccupancyMaxActiveBlocksPerMultiprocessor(&per_cu, (const void*)hymba_fwd, NTHR, LDS_BYTES) != hipSuccess || per_cu < 1) { fprintf(stderr, "kernel_launch: occupancy query says %d blocks per CU\n", per_cu); per_cu = 1; }
        (void)hipGetLastError();
        grid = cus * 1;
        fprintf(stderr, "kernel_launch: grid %d (cus %d, per_cu %d)\n", grid, cus, per_cu);
    }
    if (grid < 0) return;
    Args a{};
    for (int i = 0; i < 25; ++i) a.in[i] = (const float*)d_in[i];
    a.out = (float*)d_out; a.ws = (unsigned char*)d_ws;
#ifdef PROBE_REP
    a.lo1 = 0; a.hi1 = PROBE_REP + 1; a.lo2 = PROBE_REP; a.hi2 = NPH;
#else
    a.lo1 = 0; a.hi1 = NPH; a.lo2 = 0; a.hi2 = 0;
#endif
    if (hipMemsetAsync(d_ws, 0, 16384, stream) != hipSuccess) { fprintf(stderr, "kernel_launch: hipMemsetAsync failed\n"); return; }
    void* args[] = {&a};
    const hipError_t e = hipLaunchCooperativeKernel((const void*)hymba_fwd, dim3(grid), dim3(NTHR), args, LDS_BYTES, stream);
    if (e != hipSuccess) fprintf(stderr, "kernel_launch: cooperative launch failed: %s (grid %d)\n", hipGetErrorString(e), grid);
}
```

```cpp
#include <hip/hip_runtime.h>
#include <hip/hip_cooperative_groups.h>
#include <cstdio>
#include <cstdint>
namespace cg = cooperative_groups;
namespace pg8 {
#define PG8_LAS __attribute__((address_space(3)))
typedef unsigned short bf16_t;
typedef short bf16x8 __attribute__((ext_vector_type(8)));
typedef float f32x4 __attribute__((ext_vector_type(4)));
typedef unsigned u32x4 __attribute__((ext_vector_type(4)));
constexpr int BM = 256, BK = 64, HALF = 128, HTB = HALF * BK * 2  , STAGE_BYTES = 8 * HTB, NXCD = 8, WGM = 8;

__host__ __device__ __forceinline__ int lds_byte(int r, int c) { const int st = (r >> 4) * 2 + (c >> 5), rr = r & 15, cc = c & 31, ob = rr * 64 + cc * 2; return st * 1024 + (ob ^ (((ob >> 9) & 1) << 5)); }
__host__ __device__ __forceinline__ void stage_rc(int b, int& R, int& C) { const int st = b / 1024, sb = b % 1024, swz = sb ^ (((sb >> 9) & 1) << 5); R = (st >> 1) * 16 + swz / 64; C = (st & 1) * 32 + (swz % 64) / 2; }
__host__ __device__ __forceinline__ int perm32(int rho) { const int n = rho >> 4, i = rho & 15; return 8 * (i >> 2) + 4 * n + (i & 3); }

struct Unit { int pm, pn; };
struct Gemm { const bf16_t* A; const bf16_t* Bt; int M, N, K; };

struct StaticOrder {
    int nM, nN, nwg, G, c;
    __host__ __device__ void init(int M, int N, int G_, int c_) { nM = M / BM; nN = N / BM; nwg = nM * nN; G = G_; c = c_; }
    __host__ __device__ bool next(int i, Unit& u) const {
        const long L = (long)i * G + c; if (L >= nwg) return false;
        int wgid = (int)L; { const int q = nwg / NXCD, r = nwg % NXCD, xcd = wgid % NXCD, off = wgid / NXCD; wgid = (xcd < r ? xcd * (q + 1) : r * (q + 1) + (xcd - r) * q) + off; }
        const int nig = WGM * nN, gid = wgid / nig, fm = gid * WGM, gsz = (nM - fm) < WGM ? (nM - fm) : WGM;
        u.pm = fm + ((wgid % nig) % gsz); u.pn = (wgid % nig) / gsz; return true;
    }
    __device__ __forceinline__ void a_ready(const Unit&) const {}
    __device__ __forceinline__ void done(const Unit&) const {}
};


__device__ __forceinline__ unsigned cvt_pk_bf16(float lo, float hi) { unsigned r; asm volatile("v_cvt_pk_bf16_f32 %0, %1, %2" : "=v"(r) : "v"(lo), "v"(hi)); return r; }
typedef unsigned u32x2 __attribute__((ext_vector_type(2)));

__device__ __forceinline__ float row_rs(const float* SS, int row, int fq) {
    const f32x4* p = (const f32x4*)(SS + (size_t)row * 32 + fq * 8);
    const f32x4 a = p[0], b = p[1];
    float s = ((a[0] + a[1]) + (a[2] + a[3])) + ((b[0] + b[1]) + (b[2] + b[3]));
    s += __shfl_xor(s, 16); s += __shfl_xor(s, 32);
    return rsqrtf(s * (1.0f / 2048.0f) + 1e-6f);
}
__device__ __forceinline__ float silu_f(float g) { return g * __builtin_amdgcn_rcpf(1.0f + __expf(-g)); }

struct EpiSwiGLU {
    static constexpr bool PERM = true, AFTER_DRAIN = false;
    bf16_t* O; int ldc; const float* SS;
    __device__ __forceinline__ void operator()(const f32x4 (&acc)[2][2][4][2], const Unit& u, int wr, int wc, int fr, int fq) const {
        const int row0 = u.pm * BM + wr * 64 + fr, col0 = u.pn * HALF + wc * 32 + 8 * fq;
#pragma unroll
        for (int ai = 0; ai < 2; ++ai)
#pragma unroll
            for (int m = 0; m < 4; ++m) {
                const int row = row0 + ai * HALF + m * 16;
                const float rs = row_rs(SS, row, fq);
                float v[8];
#pragma unroll
                for (int n = 0; n < 2; ++n)
#pragma unroll
                    for (int j = 0; j < 4; ++j) { const float g = acc[ai][0][m][n][j] * rs, up = acc[ai][1][m][n][j] * rs; v[n * 4 + j] = silu_f(g) * up; }
                u32x4 w; w.x = cvt_pk_bf16(v[0], v[1]); w.y = cvt_pk_bf16(v[2], v[3]); w.z = cvt_pk_bf16(v[4], v[5]); w.w = cvt_pk_bf16(v[6], v[7]);
                *(u32x4*)(O + (size_t)row * ldc + col0) = w;
            }
    }
};

struct EpiResid {
    static constexpr bool PERM = false, AFTER_DRAIN = false;
    const float* base; float* out; int ldc; float alpha; bf16_t* XN; const float* gain; float* SS;
    __device__ __forceinline__ void operator()(const f32x4 (&acc)[2][2][4][2], const Unit& u, int wr, int wc, int fr, int fq) const {
        const int row0 = u.pm * BM + wr * 64 + fr, col0 = u.pn * BM + wc * 32 + 4 * fq;
#pragma unroll
        for (int ai = 0; ai < 2; ++ai)
#pragma unroll
            for (int m = 0; m < 4; ++m) {
                const int row = row0 + ai * HALF + m * 16; const size_t off = (size_t)row * ldc + col0; float ssq = 0.f;
#pragma unroll
                for (int bj = 0; bj < 2; ++bj)
#pragma unroll
                    for (int n = 0; n < 2; ++n) { const int c = bj * HALF + n * 16;
                        const f32x4 b = *(const f32x4*)(base + off + c); const f32x4 o = b + acc[ai][bj][m][n] * alpha;
                        *(f32x4*)(out + off + c) = o;
                        if (XN) { const f32x4 gv = *(const f32x4*)(gain + col0 + c); const f32x4 w = o * gv;
                            u32x2 pk; pk.x = cvt_pk_bf16(w[0], w[1]); pk.y = cvt_pk_bf16(w[2], w[3]); *(u32x2*)(XN + off + c) = pk;
                            ssq += (o[0] * o[0] + o[1] * o[1]) + (o[2] * o[2] + o[3] * o[3]); } }
                if (SS) { ssq += __shfl_xor(ssq, 16); ssq += __shfl_xor(ssq, 32); if (fq == 0) SS[(size_t)row * 32 + u.pn * 4 + wc] = ssq; }
                asm volatile("" ::: "memory");
            }
    }
};

template <bool LRX> struct EpiScale {
    static constexpr bool PERM = true, AFTER_DRAIN = false;
    bf16_t* O; int ldc; const float* SS; float* LR;
    __device__ __forceinline__ void operator()(const f32x4 (&acc)[2][2][4][2], const Unit& u, int wr, int wc, int fr, int fq) const {
        const int row0 = u.pm * BM + wr * 64 + fr, col0 = u.pn * BM + wc * 32 + 8 * fq;
#pragma unroll
        for (int ai = 0; ai < 2; ++ai)
#pragma unroll
            for (int m = 0; m < 4; ++m) {
                const int row = row0 + ai * HALF + m * 16;
                const float rs = SS ? row_rs(SS, row, fq) : 1.0f;
#pragma unroll
                for (int bj = 0; bj < 2; ++bj) { const f32x4 v0 = acc[ai][bj][m][0] * rs, v1 = acc[ai][bj][m][1] * rs;
                    u32x4 w; w.x = cvt_pk_bf16(v0[0], v0[1]); w.y = cvt_pk_bf16(v0[2], v0[3]); w.z = cvt_pk_bf16(v1[0], v1[1]); w.w = cvt_pk_bf16(v1[2], v1[3]);
                    *(u32x4*)(O + (size_t)row * ldc + col0 + bj * HALF) = w;
                    if (LRX) { if (u.pn == 12 && bj == 0 && wc == 0 && fq < 2) { *(f32x4*)(LR + (size_t)row * 16 + 8 * fq) = v0; *(f32x4*)(LR + (size_t)row * 16 + 8 * fq + 4) = v1; } } }
            }
    }
};
template <class Epi, class Sched, bool ALIGN_EPI = false, bool SP2 = false>
__device__ __forceinline__ void gemm_phase(PG8_LAS unsigned char* lds, const Gemm g, const Sched& S, const Epi& E) {
    const int tid = threadIdx.x, wid = __builtin_amdgcn_readfirstlane(tid >> 6), lane = tid & 63, wr = wid >> 2, wc = wid & 3, fr = lane & 15, fq = lane >> 4;
    const int K = g.K, nt = K / BK;
    unsigned voffA[2], voffB[2];
#pragma unroll
    for (int i = 0; i < 2; ++i) { int R, C; stage_rc(tid * 16 + i * 8192, R, C); const int Rb = Epi::PERM ? ((R & ~31) + perm32(R & 31)) : R;
        voffA[i] = (unsigned)(R * K + C) * 2u; voffB[i] = (unsigned)(Rb * K + C) * 2u; }
    const size_t kstep = (size_t)(BK * 2);
    const size_t hstep = (size_t)HALF * K * 2;
    const size_t tstep = 2 * hstep;
    const unsigned ldsw = (unsigned)wid * 1024u;
    const int aoff = lds_byte(wr * 64 + fr, fq * 8), boff = lds_byte(wc * 32 + fr, fq * 8);
#define PG8_SA(b, h) (((b) * 2 + (h)) * HTB)
#define PG8_SB(b, h) ((4 + (b) * 2 + (h)) * HTB)
#define PG8_STAGE(bufoff, gbase, voff) do { _Pragma("unroll") for (int _i = 0; _i < 2; ++_i) \
        __builtin_amdgcn_global_load_lds((const unsigned*)((const char*)(gbase) + (voff)[_i]), (PG8_LAS unsigned*)(lds + (bufoff) + ldsw + _i * 8192), 16, 0, 0); } while (0)
#define PG8_LDA(dst, b, h) do { _Pragma("unroll") for (int m = 0; m < 4; ++m) _Pragma("unroll") for (int k = 0; k < 2; ++k) dst[m][k] = *(const PG8_LAS bf16x8*)(lds + PG8_SA(b, h) + aoff + m * 2048 + k * 1024); } while (0)
#define PG8_LDB(dst, b, h) do { _Pragma("unroll") for (int n = 0; n < 2; ++n) _Pragma("unroll") for (int k = 0; k < 2; ++k) dst[n][k] = *(const PG8_LAS bf16x8*)(lds + PG8_SB(b, h) + boff + n * 2048 + k * 1024); } while (0)
#define PG8_MMA(ai, bj, At, Bt) do { __builtin_amdgcn_s_setprio(1); _Pragma("unroll") for (int m = 0; m < 4; ++m) _Pragma("unroll") for (int n = 0; n < 2; ++n) _Pragma("unroll") for (int k = 0; k < 2; ++k) \
        acc[ai][bj][m][n] = __builtin_amdgcn_mfma_f32_16x16x32_bf16(Bt[n][k], At[m][k], acc[ai][bj][m][n], 0, 0, 0); __builtin_amdgcn_s_setprio(0); } while (0)
#define PG8_WAIT_V(n) asm volatile("s_waitcnt vmcnt(" #n ")" ::: "memory")
#define PG8_WAIT_L(n) asm volatile("s_waitcnt lgkmcnt(" #n ")" ::: "memory")
#define PG8_BAR __builtin_amdgcn_s_barrier()
#define PG8_SCHED __builtin_amdgcn_sched_barrier(0)
    Unit cur, nxt; int ui = 0;
    if (!S.next(0, cur)) return;
    f32x4 acc[2][2][4][2];
#pragma unroll
    for (int a = 0; a < 2; ++a)
#pragma unroll
        for (int b = 0; b < 2; ++b)
#pragma unroll
            for (int m = 0; m < 4; ++m)
#pragma unroll
                for (int n = 0; n < 2; ++n) acc[a][b][m][n] = (f32x4){0.f, 0.f, 0.f, 0.f};
    bf16x8 At[4][2], B0[2][2], B1[2][2];
    const char* cA = (const char*)g.A + (size_t)cur.pm * tstep; const char* cB = (const char*)g.Bt + (size_t)cur.pn * tstep;
    S.a_ready(cur);
    if constexpr (SP2) {
        PG8_STAGE(PG8_SB(0, 0), cB, voffB); PG8_STAGE(PG8_SB(0, 1), cB + hstep, voffB); PG8_STAGE(PG8_SA(0, 0), cA, voffA); PG8_STAGE(PG8_SA(0, 1), cA + hstep, voffA);
        if (wr == 1) PG8_BAR;
        PG8_WAIT_V(2); PG8_BAR;
        PG8_STAGE(PG8_SB(1, 0), cB + kstep, voffB); PG8_STAGE(PG8_SA(1, 0), cA + kstep, voffA); PG8_STAGE(PG8_SB(1, 1), cB + hstep + kstep, voffB);
        PG8_WAIT_V(6); PG8_BAR;
    } else {
        PG8_STAGE(PG8_SB(0, 0), cB, voffB); PG8_STAGE(PG8_SA(0, 0), cA, voffA); PG8_STAGE(PG8_SB(0, 1), cB + hstep, voffB); PG8_STAGE(PG8_SA(0, 1), cA + hstep, voffA);
        if (wr == 1) PG8_BAR;
        PG8_WAIT_V(4); PG8_BAR;
        PG8_STAGE(PG8_SB(1, 0), cB + kstep, voffB); PG8_STAGE(PG8_SA(1, 0), cA + kstep, voffA); PG8_STAGE(PG8_SB(1, 1), cB + hstep + kstep, voffB);
        PG8_WAIT_V(6); PG8_BAR;
    }
    for (;;) {
        const bool has_next = S.next(ui + 1, nxt);
        const char* nA = has_next ? (const char*)g.A + (size_t)nxt.pm * tstep : cA; const char* nB = has_next ? (const char*)g.Bt + (size_t)nxt.pn * tstep : cB;
        for (int t = 0; t < nt; t += 2) {
            const bool last = (t == nt - 2);
            const char* a1 = cA + (size_t)(t + 1) * kstep;
            const char* a2 = last ? nA : cA + (size_t)(t + 2) * kstep; const char* b2 = last ? nB : cB + (size_t)(t + 2) * kstep;
            const char* a3 = a2 + kstep; const char* b3 = b2 + kstep;
            if (last && has_next) S.a_ready(nxt);
            if constexpr (SP2) {
            PG8_LDB(B0, 0, 0); PG8_LDB(B1, 0, 1); PG8_SCHED; PG8_LDA(At, 0, 0); PG8_STAGE(PG8_SA(1, 1), a1 + hstep, voffA);
            PG8_WAIT_V(8); PG8_WAIT_L(0); PG8_BAR; PG8_MMA(0, 0, At, B0); PG8_MMA(0, 1, At, B1); PG8_BAR; PG8_SCHED;
            PG8_LDA(At, 0, 1); PG8_STAGE(PG8_SB(0, 0), b2, voffB); PG8_STAGE(PG8_SB(0, 1), b2 + hstep, voffB); PG8_STAGE(PG8_SA(0, 0), a2, voffA);
            PG8_WAIT_V(8); PG8_WAIT_L(0); PG8_BAR; PG8_MMA(1, 0, At, B0); PG8_MMA(1, 1, At, B1); PG8_BAR; PG8_SCHED;
            PG8_LDB(B0, 1, 0); PG8_LDB(B1, 1, 1); PG8_SCHED; PG8_LDA(At, 1, 0); PG8_STAGE(PG8_SA(0, 1), a2 + hstep, voffA);
            PG8_WAIT_V(8); PG8_WAIT_L(0); PG8_BAR; PG8_MMA(0, 0, At, B0); PG8_MMA(0, 1, At, B1); PG8_BAR; PG8_SCHED;
            PG8_LDA(At, 1, 1); PG8_STAGE(PG8_SB(1, 0), b3, voffB); PG8_STAGE(PG8_SB(1, 1), b3 + hstep, voffB); PG8_STAGE(PG8_SA(1, 0), a3, voffA);
            PG8_WAIT_V(8); PG8_WAIT_L(0); PG8_BAR; PG8_MMA(1, 0, At, B0); PG8_MMA(1, 1, At, B1); PG8_BAR; PG8_SCHED;
            } else {
            PG8_LDB(B0, 0, 0); PG8_SCHED; PG8_LDA(At, 0, 0); PG8_STAGE(PG8_SA(1, 1), a1 + hstep, voffA);
            PG8_WAIT_L(8); PG8_BAR; PG8_WAIT_L(0); PG8_MMA(0, 0, At, B0); PG8_BAR; PG8_SCHED;
            PG8_LDB(B1, 0, 1); PG8_STAGE(PG8_SB(0, 0), b2, voffB);
            PG8_BAR; PG8_WAIT_L(0); PG8_MMA(0, 1, At, B1); PG8_BAR;
            PG8_LDA(At, 0, 1); PG8_STAGE(PG8_SA(0, 0), a2, voffA);
            PG8_BAR; PG8_WAIT_L(0); PG8_MMA(1, 0, At, B0); PG8_BAR; PG8_SCHED;
            PG8_STAGE(PG8_SB(0, 1), b2 + hstep, voffB);
            PG8_WAIT_V(6); PG8_BAR; PG8_MMA(1, 1, At, B1); PG8_BAR;
            PG8_LDB(B0, 1, 0); PG8_SCHED; PG8_LDA(At, 1, 0); PG8_STAGE(PG8_SA(0, 1), a2 + hstep, voffA);
            PG8_WAIT_L(8); PG8_BAR; PG8_WAIT_L(0); PG8_MMA(0, 0, At, B0); PG8_BAR; PG8_SCHED;
            PG8_LDB(B1, 1, 1); PG8_STAGE(PG8_SB(1, 0), b3, voffB);
            PG8_BAR; PG8_WAIT_L(0); PG8_MMA(0, 1, At, B1); PG8_BAR;
            PG8_LDA(At, 1, 1); PG8_STAGE(PG8_SA(1, 0), a3, voffA);
            PG8_BAR; PG8_WAIT_L(0); PG8_MMA(1, 0, At, B0); PG8_BAR; PG8_SCHED;
            PG8_STAGE(PG8_SB(1, 1), b3 + hstep, voffB);
            PG8_WAIT_V(6); PG8_BAR; PG8_MMA(1, 1, At, B1); PG8_BAR;
            }
        }
        if constexpr (ALIGN_EPI) { if (wr == 0) PG8_BAR; }
        if constexpr (!Epi::AFTER_DRAIN) { E(acc, cur, wr, wc, fr, fq); S.done(cur); }
        if (!has_next) break;
#pragma unroll
        for (int a = 0; a < 2; ++a)
#pragma unroll
            for (int b = 0; b < 2; ++b)
#pragma unroll
                for (int m = 0; m < 4; ++m)
#pragma unroll
                    for (int n = 0; n < 2; ++n) acc[a][b][m][n] = (f32x4){0.f, 0.f, 0.f, 0.f};
        cur = nxt; cA = nA; cB = nB; ++ui;
        if constexpr (ALIGN_EPI) { if (wr == 1) PG8_BAR; }
    }
    PG8_WAIT_V(0);
    if constexpr (!ALIGN_EPI) { if (wr == 0) PG8_BAR; }
    PG8_BAR;
    if constexpr (Epi::AFTER_DRAIN) { E.fused(acc, cur, wr, wc, fr, fq, lds, wid, lane); S.done(cur); }
#undef PG8_SA
#undef PG8_SB
#undef PG8_STAGE
#undef PG8_LDA
#undef PG8_LDB
#undef PG8_MMA
#undef PG8_WAIT_V
#undef PG8_WAIT_L
#undef PG8_BAR
#undef PG8_SCHED
}
}

constexpr int NWAVES = 8, NTHR = 512;
constexpr int B_ = 2, T_ = 4096, D_ = 2048, M_ = B_ * T_, FF_ = 5632, NGU = 2 * FF_, MEML = 256, MM_ = B_ * MEML;
constexpr int NIN = 6160, NINP = 6400;
constexpr int GQ_OFF = 0, GK_OFF = 512, GV_OFF = 1024, GR_OFF = 2048, MQ_OFF = 3072, MK_OFF = 4096, MV_OFF = 5120, NU = 6144;
constexpr float EPS = 1e-6f;
#ifndef MK_MULTI
#define MK_MULTI 0
#endif
#ifndef ANCHOR_GLA
#define ANCHOR_GLA 0
#endif
#ifndef ANCHOR_MOBA
#define ANCHOR_MOBA 0
#endif
#ifndef ANCHOR_XATTN
#define ANCHOR_XATTN 0
#endif
constexpr int NPH = 13;

constexpr size_t MiB = 1u << 20;
constexpr size_t WS_W1GU = 1 * MiB, WS_W1D = 45 * MiB, WS_W2GU = 67 * MiB, WS_W2D = 111 * MiB, WS_WIN = 133 * MiB, WS_WOUT = 158 * MiB,
                 WS_WQ = 166 * MiB, WS_WKV = 168 * MiB, WS_WO = 172 * MiB;
constexpr size_t WS_XN = 174 * MiB, WS_MEMN = 206 * MiB, WS_SS = 208 * MiB;
constexpr size_t WS_ACT = 209 * MiB;
constexpr size_t WS_XQ = WS_ACT, WS_XO = WS_ACT + 8 * MiB, WS_MKV = WS_ACT + 16 * MiB;
constexpr size_t WS_LR = 309 * MiB, WS_LA = 310 * MiB, WS_MIX = 326 * MiB, WS_KMEAN = 358 * MiB, WS_END = 359 * MiB;
constexpr int LDS_BYTES = 147456;

#define LAS __attribute__((address_space(3)))
typedef unsigned short bf16;
typedef unsigned v4u __attribute__((ext_vector_type(4)));
typedef unsigned v2u __attribute__((ext_vector_type(2)));
typedef float f32x4 __attribute__((ext_vector_type(4)));
typedef float f32x2 __attribute__((ext_vector_type(2)));
#define LDS_WAIT() asm volatile("s_waitcnt lgkmcnt(0)" ::: "memory")
__device__ __forceinline__ unsigned f2bf(float f) { unsigned u = __builtin_bit_cast(unsigned, f); return (u + 0x7fffu + ((u >> 16) & 1u)) >> 16; }
__device__ __forceinline__ unsigned pk2(float lo, float hi) { return f2bf(lo) | (f2bf(hi) << 16); }
__device__ __forceinline__ float bflo(unsigned u) { return __builtin_bit_cast(float, u << 16); }
__device__ __forceinline__ float bfhi(unsigned u) { return __builtin_bit_cast(float, u & 0xffff0000u); }
__device__ __forceinline__ float wave_sum(float v) {
#pragma unroll
    for (int o = 1; o < 64; o <<= 1) v += __shfl_xor(v, o);
    return v;
}


#ifndef ATT_NOMASK
#define ATT_NOMASK 0
#endif
#ifndef ATT_NOGATE
#define ATT_NOGATE 0
#endif
namespace att {
typedef unsigned short bf16;
using bf16x8 = __attribute__((ext_vector_type(8))) short;
using s16x4  = __attribute__((ext_vector_type(4))) short;
using f32x16 = __attribute__((ext_vector_type(16))) float;
using f32x4  = __attribute__((ext_vector_type(4))) float;
using u32x4  = __attribute__((ext_vector_type(4))) unsigned;
constexpr int   D = 128, NW = 8, QBLK = 32, KVBLK = 64;
constexpr float SCALE = 0.088388347648318440f;
constexpr float THR = 8.f;
constexpr size_t SHM_V = KVBLK * D * 2, SHM_K = KVBLK * D * 2, SHM_ATTN = 2 * SHM_V + 2 * SHM_K + NW * 64 * 4;
#define KSWZ(row, colB) ((row) * 256 + ((colB) ^ (((row) & 7) << 4)))
#define SBAR() __builtin_amdgcn_sched_barrier(0)
__device__ __forceinline__ int crow(int r, int hi) { return (r & 3) + 8 * (r >> 2) + 4 * hi; }
__device__ __forceinline__ unsigned cvtpk(float lo, float hi) { unsigned r; asm volatile("v_cvt_pk_bf16_f32 %0, %1, %2" : "=v"(r) : "v"(lo), "v"(hi)); return r; }
__device__ __forceinline__ float blo(unsigned u) { return __builtin_bit_cast(float, u << 16); }
__device__ __forceinline__ float bhi(unsigned u) { return __builtin_bit_cast(float, u & 0xffff0000u); }

__device__ __forceinline__ void partialSM(f32x16& p0, f32x16& p1, float& m_reg, float& mn, float& alpha) {
  constexpr float C = SCALE * 1.4426950408889634f;
  float pmax = p0[0]; for (int r = 1; r < 16; ++r) pmax = fmaxf(pmax, p0[r]); for (int r = 0; r < 16; ++r) pmax = fmaxf(pmax, p1[r]);
  { auto rr = __builtin_amdgcn_permlane32_swap(__float_as_uint(pmax), __float_as_uint(pmax), false, false);
    pmax = fmaxf(__uint_as_float(rr[0]), __uint_as_float(rr[1])); }
  if (__builtin_expect(__all(pmax - m_reg <= THR / SCALE), 1)) { mn = m_reg; alpha = 1.f; }
  else { mn = fmaxf(m_reg, pmax); alpha = __builtin_amdgcn_exp2f((m_reg - mn) * C); m_reg = mn; }
  float mnC = -mn * C;
  for (int r = 0; r < 16; ++r) p0[r] = fmaf(p0[r], C, mnC); for (int r = 0; r < 16; ++r) p1[r] = fmaf(p1[r], C, mnC);
  for (int r = 0; r < 16; ++r) p0[r] = __builtin_amdgcn_exp2f(p0[r]);
}
__device__ __forceinline__ void finishSM(f32x16& p0, f32x16& p1, float alpha, float& l_reg, bf16x8& pa0, bf16x8& pa1, bf16x8& pa2, bf16x8& pa3) {
  for (int r = 0; r < 16; ++r) p1[r] = __builtin_amdgcn_exp2f(p1[r]);
  float ps = 0; for (int r = 0; r < 16; ++r) ps += p0[r]; for (int r = 0; r < 16; ++r) ps += p1[r];
  { auto rr = __builtin_amdgcn_permlane32_swap(__float_as_uint(ps), __float_as_uint(ps), false, false);
    ps = __uint_as_float(rr[0]) + __uint_as_float(rr[1]); }
  l_reg = l_reg * alpha + ps;
#define PK4(P, BASE, OUT) do { unsigned a0 = cvtpk(P[BASE + 0], P[BASE + 1]), a1 = cvtpk(P[BASE + 2], P[BASE + 3]);   \
    unsigned b0 = cvtpk(P[BASE + 4], P[BASE + 5]), b1 = cvtpk(P[BASE + 6], P[BASE + 7]);                              \
    auto r0 = __builtin_amdgcn_permlane32_swap(a0, b0, false, false); auto r1 = __builtin_amdgcn_permlane32_swap(a1, b1, false, false); \
    u32x4 w = {r0[0], r1[0], r0[1], r1[1]}; OUT = *reinterpret_cast<bf16x8*>(&w); } while (0)
  PK4(p0, 0, pa0); PK4(p0, 8, pa1); PK4(p1, 0, pa2); PK4(p1, 8, pa3);
#undef PK4
}
__device__ __forceinline__ void qkt(f32x16& p0, f32x16& p1, const bf16* Ks, const bf16x8* qr, int r32, int hi) {
  p0 = f32x16{}; p1 = f32x16{};
  for (int d0 = 0; d0 < 8; ++d0) { int cb = (d0 * 16 + hi * 8) * 2;
    bf16x8 b0 = *reinterpret_cast<const bf16x8*>((const char*)Ks + KSWZ(r32, cb));
    bf16x8 b1 = *reinterpret_cast<const bf16x8*>((const char*)Ks + KSWZ(32 + r32, cb));
    p0 = __builtin_amdgcn_mfma_f32_32x32x16_bf16(b0, qr[d0], p0, 0, 0, 0);
    p1 = __builtin_amdgcn_mfma_f32_32x32x16_bf16(b1, qr[d0], p1, 0, 0, 0); }
}
__device__ __forceinline__ void qkt_l(f32x16& p0, f32x16& p1, const bf16* Ks, const char* Qs, int qrow, int r32, int hi) {
  p0 = f32x16{}; p1 = f32x16{};
  int qopq = 0; asm volatile("" : "+v"(qopq));
  for (int d0 = 0; d0 < 8; ++d0) { int cb = (d0 * 16 + hi * 8) * 2;
    bf16x8 b0 = *reinterpret_cast<const bf16x8*>((const char*)Ks + KSWZ(r32, cb));
    bf16x8 b1 = *reinterpret_cast<const bf16x8*>((const char*)Ks + KSWZ(32 + r32, cb));
    bf16x8 q = *reinterpret_cast<const bf16x8*>(Qs + qopq + KSWZ(qrow, cb));
    p0 = __builtin_amdgcn_mfma_f32_32x32x16_bf16(b0, q, p0, 0, 0, 0);
    p1 = __builtin_amdgcn_mfma_f32_32x32x16_bf16(b1, q, p1, 0, 0, 0); }
}
__device__ __forceinline__ int v_st(int k, int c) { const int kk = (k & ~0xC) | ((k & 4) << 1) | ((k & 8) >> 1); return ((kk >> 3) * 4 + (c >> 5)) * 512 + ((kk & 7) * 32 + (c & 31)) * 2; }
__device__ __forceinline__ int v_rd_base(int lane) { return ((lane & 3) << 3) | (((lane >> 2) & 3) << 6) | (((lane >> 4) & 1) << 5) | (((lane >> 5) & 1) << 8); }
constexpr int v_rd_off(int d0, int ks, int half) { return d0 * 512 + ks * 4096 + half * 2048; }
template <int OFF> __device__ __forceinline__ s16x4 tr_read(int vb) {
  s16x4 r; asm volatile("ds_read_b64_tr_b16 %0, %1 offset:%2" : "=&v"(r) : "v"(vb), "i"(OFF) : "memory"); return r;
}
template <int D0> __device__ __forceinline__ void pv_one(f32x16& od, int vb, bf16x8 pa0, bf16x8 pa1, bf16x8 pa2, bf16x8 pa3) {
  const s16x4 l0 = tr_read<v_rd_off(D0, 0, 0)>(vb), h0 = tr_read<v_rd_off(D0, 0, 1)>(vb), l1 = tr_read<v_rd_off(D0, 1, 0)>(vb), h1 = tr_read<v_rd_off(D0, 1, 1)>(vb);
  const s16x4 l2 = tr_read<v_rd_off(D0, 2, 0)>(vb), h2 = tr_read<v_rd_off(D0, 2, 1)>(vb), l3 = tr_read<v_rd_off(D0, 3, 0)>(vb), h3 = tr_read<v_rd_off(D0, 3, 1)>(vb);
  asm volatile("s_waitcnt lgkmcnt(0)" ::: "memory"); SBAR();
#define PK(L, H) (bf16x8){L[0], L[1], L[2], L[3], H[0], H[1], H[2], H[3]}
  od = __builtin_amdgcn_mfma_f32_32x32x16_bf16(pa0, PK(l0, h0), od, 0, 0, 0);
  od = __builtin_amdgcn_mfma_f32_32x32x16_bf16(pa1, PK(l1, h1), od, 0, 0, 0);
  od = __builtin_amdgcn_mfma_f32_32x32x16_bf16(pa2, PK(l2, h2), od, 0, 0, 0);
  od = __builtin_amdgcn_mfma_f32_32x32x16_bf16(pa3, PK(l3, h3), od, 0, 0, 0);
#undef PK
}
__device__ __forceinline__ void pv_d0(f32x16* o, int vb, bf16x8 pa0, bf16x8 pa1, bf16x8 pa2, bf16x8 pa3) {
  pv_one<0>(o[0], vb, pa0, pa1, pa2, pa3); pv_one<1>(o[1], vb, pa0, pa1, pa2, pa3); pv_one<2>(o[2], vb, pa0, pa1, pa2, pa3); pv_one<3>(o[3], vb, pa0, pa1, pa2, pa3);
}
__device__ __forceinline__ bf16x8 knorm8(bf16x8 v, const float* g) {
  const u32x4 w = *reinterpret_cast<const u32x4*>(&v);
  float f[8] = {blo(w.x), bhi(w.x), blo(w.y), bhi(w.y), blo(w.z), bhi(w.z), blo(w.w), bhi(w.w)};
  float ss = 0.f;
#pragma unroll
  for (int i = 0; i < 8; ++i) ss += f[i] * f[i];
  ss += __shfl_xor(ss, 1); ss += __shfl_xor(ss, 2); ss += __shfl_xor(ss, 4); ss += __shfl_xor(ss, 8);
  const float rs = rsqrtf(ss * (1.0f / 128.0f) + 1e-6f);
  u32x4 o = {cvtpk(f[0] * rs * g[0], f[1] * rs * g[1]), cvtpk(f[2] * rs * g[2], f[3] * rs * g[3]), cvtpk(f[4] * rs * g[4], f[5] * rs * g[5]), cvtpk(f[6] * rs * g[6], f[7] * rs * g[7])};
  return *reinterpret_cast<bf16x8*>(&o);
}

template <int LDQ, int LDK, int LDO, int MODE, int SD, int VOFFB, bool PIPE, bool QL>
__device__ __forceinline__ void attn_body(const bf16* __restrict__ Qb, const bf16* __restrict__ Kh, bf16* __restrict__ Ob, int seq, char* lds,
                                          const float* __restrict__ gq, const float* __restrict__ gk, const float* __restrict__ kmean, int qblk) {
  const int tid = threadIdx.x, wid = tid >> 6, lane = tid & 63, r32 = lane & 31, hi = lane >> 5;
  bf16* V_lds = (bf16*)lds; bf16* K_lds = (bf16*)(lds + 2 * SHM_V);
  float* ws = (float*)(lds + 2 * SHM_V + 2 * SHM_K) + wid * 64; float* li_l = ws; float* al_l = ws + 32;
  float m_reg = -1e30f, l_reg = 0; f32x16 o[4] = {}; bf16x8 qr[8];
  const bf16* Qw = Qb + (long)(wid * QBLK + r32) * LDQ + hi * 8;
#pragma unroll
  for (int d0 = 0; d0 < 8; ++d0) qr[d0] = *reinterpret_cast<const bf16x8*>(Qw + d0 * 16);
  unsigned sel = 0;
  if constexpr (MODE == 0) {
    float ss = 0.f;
#pragma unroll
    for (int d0 = 0; d0 < 8; ++d0) { const u32x4 w = *reinterpret_cast<const u32x4*>(&qr[d0]);
      const float f[8] = {blo(w.x), bhi(w.x), blo(w.y), bhi(w.y), blo(w.z), bhi(w.z), blo(w.w), bhi(w.w)};
#pragma unroll
      for (int i = 0; i < 8; ++i) ss += f[i] * f[i]; }
    ss += __shfl_xor(ss, 32);
    const float rs = rsqrtf(ss * (1.0f / 128.0f) + 1e-6f);
#pragma unroll
    for (int d0 = 0; d0 < 8; ++d0) { const u32x4 w = *reinterpret_cast<const u32x4*>(&qr[d0]);
      const f32x4 g0 = *reinterpret_cast<const f32x4*>(gq + d0 * 16 + hi * 8), g1 = *reinterpret_cast<const f32x4*>(gq + d0 * 16 + hi * 8 + 4);
      u32x4 ow = {cvtpk(blo(w.x) * rs * g0[0], bhi(w.x) * rs * g0[1]), cvtpk(blo(w.y) * rs * g0[2], bhi(w.y) * rs * g0[3]), cvtpk(blo(w.z) * rs * g1[0], bhi(w.z) * rs * g1[1]), cvtpk(blo(w.w) * rs * g1[2], bhi(w.w) * rs * g1[3])};
      qr[d0] = *reinterpret_cast<bf16x8*>(&ow); }
  }
  if constexpr (MODE == 1 && !ATT_NOGATE) {
    float* km_l = (float*)(lds + SHM_ATTN + 512 + 65536);
    *reinterpret_cast<f32x4*>(km_l + tid * 4) = *reinterpret_cast<const f32x4*>(kmean + tid * 4); __syncthreads();
    float b1 = -3e38f, b2 = -3e38f, b3 = -3e38f; int i1 = -1, i2 = -1, i3 = -1;
#pragma unroll 1
    for (int n = 0; n < qblk; ++n) { float acc = 0.f;
#pragma unroll
      for (int d0 = 0; d0 < 8; ++d0) { const u32x4 w = *reinterpret_cast<const u32x4*>(&qr[d0]); const float* kp = km_l + n * 128 + d0 * 16 + hi * 8;
        const f32x4 k0 = *reinterpret_cast<const f32x4*>(kp), k1 = *reinterpret_cast<const f32x4*>(kp + 4);
        acc += blo(w.x) * k0[0] + bhi(w.x) * k0[1] + blo(w.y) * k0[2] + bhi(w.y) * k0[3] + blo(w.z) * k1[0] + bhi(w.z) * k1[1] + blo(w.w) * k1[2] + bhi(w.w) * k1[3]; }
      acc += __shfl_xor(acc, 32);
      if (acc > b1) { b3 = b2; i3 = i2; b2 = b1; i2 = i1; b1 = acc; i1 = n; } else if (acc > b2) { b3 = b2; i3 = i2; b2 = acc; i2 = n; } else if (acc > b3) { b3 = acc; i3 = n; } }
    sel = (i1 >= 0 ? 1u << i1 : 0u) | (i2 >= 0 ? 1u << i2 : 0u) | (i3 >= 0 ? 1u << i3 : 0u);
    asm volatile("" : "+v"(sel));
  }
  const char* Q_lds = lds + SHM_ATTN + 512; const int qrow = wid * QBLK + r32;
  if constexpr (QL) {
#pragma unroll
    for (int d0 = 0; d0 < 8; ++d0) *reinterpret_cast<bf16x8*>((char*)Q_lds + KSWZ(qrow, (d0 * 16 + hi * 8) * 2)) = qr[d0];
  }
#define QKT(P0, P1, KS) do { if constexpr (QL) qkt_l(P0, P1, KS, Q_lds, qrow, r32, hi); else qkt(P0, P1, KS, qr, r32, hi); } while (0)
  const int sr = tid >> 4, sc = (tid & 15) * 8, vst0 = v_st(sr, sc), vst1 = v_st(32 + sr, sc);
  const float* gk_l = (const float*)(lds + SHM_ATTN);
  if constexpr (MODE == 0) { if (tid < 128) ((float*)(lds + SHM_ATTN))[tid] = gk[tid]; __syncthreads(); }
  const int vb0 = (int)(uintptr_t)V_lds + v_rd_base(lane);
  struct { bf16x8 vs0, vs1, ks0, ks1; } sr_[2];
  const unsigned toff = (unsigned)(sr * LDK + sc) * 2u;
#define SLOAD(i, k0) do { const char* kb_ = (const char*)Kh + (size_t)(k0) * (size_t)(LDK * 2); \
    sr_[i].vs0 = *reinterpret_cast<const bf16x8*>(kb_ + VOFFB + toff); sr_[i].vs1 = *reinterpret_cast<const bf16x8*>(kb_ + (VOFFB + 32 * LDK * 2) + toff); \
    sr_[i].ks0 = *reinterpret_cast<const bf16x8*>(kb_ + toff); sr_[i].ks1 = *reinterpret_cast<const bf16x8*>(kb_ + (32 * LDK * 2) + toff); } while (0)
#define KN(x) ((MODE == 0) ? knorm8((x), gk_l + sc) : (x))
#define SWRITE(b, i) do { *(bf16x8*)((char*)V_lds + (b) * SHM_V + vst0) = sr_[i].vs0;          \
    *(bf16x8*)((char*)V_lds + (b) * SHM_V + vst1) = sr_[i].vs1; int kc = sc * 2;               \
    *(bf16x8*)((char*)K_lds + (b) * SHM_K + KSWZ(sr, kc)) = KN(sr_[i].ks0);                       \
    *(bf16x8*)((char*)K_lds + (b) * SHM_K + KSWZ(32 + sr, kc)) = KN(sr_[i].ks1); } while (0)
#define SWAIT() do { if constexpr (SD == 2) asm volatile("s_waitcnt vmcnt(4)" ::: "memory"); else asm volatile("s_waitcnt vmcnt(0)" ::: "memory"); } while (0)
#define RESC(a) do { if (__any((a) < 1.f)) { if (hi == 0) al_l[r32] = (a); asm volatile("s_waitcnt lgkmcnt(0)" ::: "memory"); \
    for (int d = 0; d < 4; ++d) for (int r = 0; r < 16; ++r) o[d][r] *= al_l[crow(r, hi)]; } } while (0)
#define MASK(P0, P1, tile) do { if constexpr (MODE == 1 && !ATT_NOMASK) { const int nb_ = (tile) >> 2; const float ninf_ = -__builtin_inff(); \
    if (nb_ < qblk) { if (!((sel >> nb_) & 1u)) { for (int r = 0; r < 16; ++r) { P0[r] = ninf_; P1[r] = ninf_; } } } \
    else { const int thr_ = rowthr - ((tile) & 3) * 64;     \
      for (int r = 0; r < 16; ++r) { const int c_ = (r & 3) + 8 * (r >> 2); if (c_ > thr_) P0[r] = ninf_; if (c_ + 32 > thr_) P1[r] = ninf_; } } } } while (0)
  const int rowthr = wid * 32 + r32 - 4 * hi;
  const int NT = seq / KVBLK;
  if constexpr (PIPE) {
  f32x16 pA0, pA1, pB0, pB1; float mnA, mnB, alA, alB; bf16x8 pa0, pa1, pa2, pa3;
  constexpr int SE = 0, SO = SD - 1;
  SLOAD(SE, 0); asm volatile("s_waitcnt vmcnt(0)" ::: "memory"); SWRITE(0, SE); __syncthreads();
  QKT(pA0, pA1, K_lds); MASK(pA0, pA1, 0); partialSM(pA0, pA1, m_reg, mnA, alA);
  SLOAD(SO, KVBLK); if constexpr (SD == 2) { if (2 < NT) SLOAD(SE, 2 * KVBLK); }
  SWAIT(); SWRITE(1, SO); __syncthreads();
  for (int j = 1; j + 1 < NT; j += 2) {
    SBAR(); QKT(pB0, pB1, (bf16*)((char*)K_lds + SHM_K)); MASK(pB0, pB1, j);
    finishSM(pA0, pA1, alA, l_reg, pa0, pa1, pa2, pa3); SBAR();
    SLOAD(SO, (j + SD) * KVBLK); SBAR();
    pv_d0(o, vb0, pa0, pa1, pa2, pa3); partialSM(pB0, pB1, m_reg, mnB, alB);
    __syncthreads(); SWAIT(); SWRITE(0, SE);
    RESC(alB); __syncthreads();
    SBAR(); QKT(pA0, pA1, K_lds); MASK(pA0, pA1, j + 1);
    finishSM(pB0, pB1, alB, l_reg, pa0, pa1, pa2, pa3); SBAR();
    if (SD == 1 || j + 3 < NT) SLOAD(SE, (j + 1 + SD) * KVBLK); SBAR();
    pv_d0(o, vb0 + (int)SHM_V, pa0, pa1, pa2, pa3); partialSM(pA0, pA1, m_reg, mnA, alA);
    __syncthreads(); SWAIT(); SWRITE(1, SO);
    RESC(alA); __syncthreads();
  }
  SBAR(); QKT(pB0, pB1, (bf16*)((char*)K_lds + SHM_K)); MASK(pB0, pB1, NT - 1);
  finishSM(pA0, pA1, alA, l_reg, pa0, pa1, pa2, pa3); SBAR();
  pv_d0(o, vb0, pa0, pa1, pa2, pa3); partialSM(pB0, pB1, m_reg, mnB, alB);
  __syncthreads(); RESC(alB);
  finishSM(pB0, pB1, alB, l_reg, pa0, pa1, pa2, pa3); SBAR();
  pv_d0(o, vb0 + (int)SHM_V, pa0, pa1, pa2, pa3);
  } else {
    f32x16 p0, p1; float mn, al; bf16x8 pa0, pa1, pa2, pa3;
#define TILE(buf, t) do { SBAR(); QKT(p0, p1, (bf16*)((char*)K_lds + (buf) * SHM_K)); MASK(p0, p1, (t)); \
      partialSM(p0, p1, m_reg, mn, al); finishSM(p0, p1, al, l_reg, pa0, pa1, pa2, pa3); RESC(al); SBAR(); \
      pv_d0(o, vb0 + (buf) * (int)SHM_V, pa0, pa1, pa2, pa3); } while (0)
    SLOAD(0, 0); asm volatile("s_waitcnt vmcnt(0)" ::: "memory"); SWRITE(0, 0); __syncthreads();
    SLOAD(1, KVBLK);
#pragma unroll 1
    for (int t = 0; t < NT; t += 2) {
      if (t + 2 < NT) SLOAD(0, (t + 2) * KVBLK);
      TILE(0, t);
      SWRITE(1, 1); __syncthreads();
      if (t + 3 < NT) SLOAD(1, (t + 3) * KVBLK);
      TILE(1, t + 1);
      if (t + 2 < NT) SWRITE(0, 0);
      __syncthreads();
    }
#undef TILE
  }
  if (hi == 0) li_l[r32] = l_reg; asm volatile("s_waitcnt lgkmcnt(0)" ::: "memory");
  float rli[16];
#pragma unroll
  for (int r = 0; r < 16; ++r) rli[r] = __builtin_amdgcn_rcpf(li_l[crow(r, hi)]);
  bf16* Ow = Ob + (long)(wid * QBLK) * LDO;
#pragma unroll
  for (int r = 0; r < 16; ++r) { int orow = crow(r, hi);
    for (int d0 = 0; d0 < 4; ++d0) Ow[(long)orow * LDO + d0 * 32 + r32] = (bf16)(cvtpk(o[d0][r] * rli[r], 0.f) & 0xffffu); }
  __syncthreads();
#undef SLOAD
#undef KN
#undef SWRITE
#undef SWAIT
#undef RESC
#undef MASK
#undef QKT
}
#undef KSWZ
#undef SBAR
}
struct Args { const float* in[25]; float* out; unsigned char* ws; int lo1, hi1, lo2, hi2; };

__device__ __forceinline__ void transpose_item(const float* W, int K, int N, bf16* WT, int dst_row0, LAS float* scr, int k0, int n0, int lane) {
    const int nn = n0 + (lane & 31); const bool ok = nn < N;
#pragma unroll 8
    for (int i = 0; i < 32; ++i) { const int kk = 2 * i + (lane >> 5); scr[kk * 33 + (lane & 31)] = ok ? W[(size_t)(k0 + kk) * N + nn] : 0.f; }
    LDS_WAIT(); asm volatile("" ::: "memory");
    const int c = lane & 7;
#pragma unroll
    for (int j = 0; j < 4; ++j) { const int n = (lane >> 3) + 8 * j; const LAS float* s = scr + (8 * c) * 33 + n;
        v4u o; o.x = pk2(s[0 * 33], s[1 * 33]); o.y = pk2(s[2 * 33], s[3 * 33]); o.z = pk2(s[4 * 33], s[5 * 33]); o.w = pk2(s[6 * 33], s[7 * 33]);
        *(v4u*)(WT + (size_t)(dst_row0 + n) * K + k0 + 8 * c) = o; }
    LDS_WAIT(); asm volatile("" ::: "memory");
}

#define XB_TMO      128
#define XB_XCNT(j)  (256  + 64 * (j))
#define XB_XSUB(j)  (1280 + 64 * (j))
#define XB_XGEN(j)  (2304 + 64 * (j))
#define XB_TOP      3328
#define XB_TOPGEN   3392
#define XCD_BAR_WORDS 3456
#define XB_SPIN_CAP (1u << 18)

__device__ __forceinline__ unsigned xb_ld(unsigned* p)              { return __hip_atomic_load(p, __ATOMIC_RELAXED, __HIP_MEMORY_SCOPE_AGENT); }
__device__ __forceinline__ unsigned xb_add(unsigned* p, unsigned v) { return __hip_atomic_fetch_add(p, v, __ATOMIC_RELAXED, __HIP_MEMORY_SCOPE_AGENT); }
__device__ __forceinline__ unsigned xb_xcc_id() { return (unsigned)__builtin_amdgcn_s_getreg((3 << 11) | 20) & 0xFu; }
#define XB_SPIN(cond, bar) do { unsigned _sp = 0; while (cond) { __builtin_amdgcn_s_sleep(1); \
    if ((++_sp & 255u) == 0u) { if (xb_ld(&(bar)[XB_TMO])) break; if (_sp > XB_SPIN_CAP) { atomicAdd(&(bar)[XB_TMO], 1u); break; } } } } while (0)

struct XcdBarrier {
    unsigned* bar; unsigned x;
    volatile LAS unsigned* st;
};

__device__ __forceinline__ XcdBarrier xcd_barrier_post(unsigned* bar, volatile LAS unsigned* st) {
    XcdBarrier b; b.bar = bar; b.x = xb_xcc_id(); b.st = st;
    if (threadIdx.x == 0) (void)xb_add(&bar[XB_XCNT(b.x)], 1u);
    return b;
}
__device__ __forceinline__ void xcd_barrier_complete(unsigned* bar, unsigned x, unsigned& nloc, unsigned& nx) {
    const unsigned G = gridDim.x * gridDim.y * gridDim.z;
    unsigned sum, cnt, mine, sp = 0u;
    for (;;) {
        sum = 0u; cnt = 0u; mine = 0u;
#pragma unroll
        for (unsigned j = 0; j < 16; ++j) { const unsigned c = xb_ld(&bar[XB_XCNT(j)]); sum += c; cnt += (c > 0u) ? 1u : 0u; mine = (j == x) ? c : mine; }
        if (sum == G) break;
        __builtin_amdgcn_s_sleep(1);
        if ((++sp & 255u) == 0u) { if (xb_ld(&bar[XB_TMO])) break; if (sp > XB_SPIN_CAP) { atomicAdd(&bar[XB_TMO], 1u); break; } }
    }
    nloc = mine > 0u ? mine : 1u; nx = cnt > 0u ? cnt : 1u;
}

__device__ __forceinline__ void xcd_barrier(const XcdBarrier& b) {
    asm volatile("s_waitcnt vmcnt(0)" ::: "memory");
    __syncthreads();
    if (threadIdx.x == 0) {
        unsigned* bar = b.bar;
        __builtin_amdgcn_s_waitcnt(0);
        unsigned nloc = b.st[0], nx = b.st[1];
        if (nloc == 0u) { xcd_barrier_complete(bar, b.x, nloc, nx); b.st[0] = nloc; b.st[1] = nx; }
        const unsigned old = xb_add(&bar[XB_XSUB(b.x)], 1u);
        const unsigned gen = old / nloc;
        if (old + 1u == (gen + 1u) * nloc) {
            __builtin_amdgcn_fence(__ATOMIC_RELEASE, "agent");
            asm volatile("s_waitcnt vmcnt(0)" ::: "memory");
            const unsigned og = xb_add(&bar[XB_TOP], 1u);
            const unsigned tg = og / nx;
            if (og + 1u == (tg + 1u) * nx) xb_add(&bar[XB_TOPGEN], 1u);
            else XB_SPIN(xb_ld(&bar[XB_TOPGEN]) == tg, bar);
            __builtin_amdgcn_fence(__ATOMIC_ACQUIRE, "agent");
            xb_add(&bar[XB_XGEN(b.x)], 1u);
            asm volatile("s_waitcnt vmcnt(0)" ::: "memory");
        } else {
            XB_SPIN(xb_ld(&bar[XB_XGEN(b.x)]) == gen, bar);
            __builtin_amdgcn_fence(__ATOMIC_ACQUIRE, "agent");
            asm volatile("s_waitcnt vmcnt(0)" ::: "memory");
        }
    }
    __syncthreads();
}
struct Item { const float* W; bf16* WT; int K, N, k0, n0, drow; };
constexpr int IT_GU = (D_ / 64) * (FF_ / 128), IT_DN = (FF_ / 64) * (D_ / 128), IT_IN = (D_ / 64) * (NINP / 128), IT_OUT = (D_ / 64) * (D_ / 128), IT_Q = (D_ / 64) * (512 / 128), IT_KV = (D_ / 64) * (1024 / 128), IT_O = (512 / 64) * (D_ / 128);
constexpr int IL_W1GU = 0, IL_W1D = 2 * IT_GU, IL_WIN = IL_W1D + IT_DN, IL_WOUT = IL_WIN + IT_IN, IL_WQ = IL_WOUT + IT_OUT, IL_WKV = IL_WQ + IT_Q, IL_WO = IL_WKV + IT_KV, IL_W2GU = IL_WO + IT_O, IL_W2D = IL_W2GU + 2 * IT_GU, IL_END = IL_W2D + IT_DN;
__device__ __forceinline__ void decode_item(int r, const Args& a, unsigned char* ws, Item& it) {
    const float* W; bf16* WT; int K, N, NP, mode = 0;
    if (r < IL_W1D) { const bool up = r >= IT_GU; r -= up ? IT_GU : 0; W = a.in[up ? 4 : 3]; WT = (bf16*)(ws + WS_W1GU); K = D_; N = FF_; NP = FF_; mode = up ? 2 : 1; }
    else if (r < IL_WIN) { r -= IL_W1D; W = a.in[5]; WT = (bf16*)(ws + WS_W1D); K = FF_; N = D_; NP = D_; }
    else if (r < IL_WOUT) { r -= IL_WIN; W = a.in[7]; WT = (bf16*)(ws + WS_WIN); K = D_; N = NIN; NP = NINP; }
    else if (r < IL_WQ) { r -= IL_WOUT; W = a.in[13]; WT = (bf16*)(ws + WS_WOUT); K = D_; N = D_; NP = D_; }
    else if (r < IL_WKV) { r -= IL_WQ; W = a.in[16]; WT = (bf16*)(ws + WS_WQ); K = D_; N = 512; NP = 512; }
    else if (r < IL_WO) { r -= IL_WKV; W = a.in[17]; WT = (bf16*)(ws + WS_WKV); K = D_; N = 1024; NP = 1024; }
    else if (r < IL_W2GU) { r -= IL_WO; W = a.in[18]; WT = (bf16*)(ws + WS_WO); K = 512; N = D_; NP = D_; }
    else if (r < IL_W2D) { r -= IL_W2GU; const bool up = r >= IT_GU; r -= up ? IT_GU : 0; W = a.in[up ? 23 : 22]; WT = (bf16*)(ws + WS_W2GU); K = D_; N = FF_; NP = FF_; mode = up ? 2 : 1; }
    else { r -= IL_W2D; W = a.in[24]; WT = (bf16*)(ws + WS_W2D); K = FF_; N = D_; NP = D_; }
    const int nblk = NP / 128, kb = r / nblk, nb = r - kb * nblk, n0 = nb * 128;
    it.W = W; it.WT = WT; it.K = K; it.N = N; it.k0 = kb * 64; it.n0 = n0;
    it.drow = mode ? nb * 256 + (mode == 2 ? 128 : 0) : n0;
}
__device__ __forceinline__ void item_convert(const Item& it, int lane) {
    const int nn = it.n0 + 2 * lane; const bool ok = nn < it.N;
    const f32x2* p = (const f32x2*)(it.W + (size_t)it.k0 * it.N + (ok ? nn : 0)); const size_t st = (size_t)(it.N >> 1);
    f32x2 v[64];
#pragma unroll
    for (int i = 0; i < 64; ++i) v[i] = p[i * st];
    if (!ok) {
#pragma unroll
        for (int i = 0; i < 64; ++i) v[i] = (f32x2){0.f, 0.f}; }
    int dr = it.drow + 2 * lane;
    if (it.N == NIN) dr = nn < 3072 ? nn : (nn < 3088 ? 6144 + (nn - 3072) : (nn < NIN ? nn - 16 : nn));
    bf16* o0 = it.WT + (size_t)dr * it.K + it.k0; bf16* o1 = o0 + it.K;
#pragma unroll
    for (int j = 0; j < 8; ++j) {
        v4u x0, x1;
        x0.x = pg8::cvt_pk_bf16(v[8 * j][0], v[8 * j + 1][0]); x0.y = pg8::cvt_pk_bf16(v[8 * j + 2][0], v[8 * j + 3][0]); x0.z = pg8::cvt_pk_bf16(v[8 * j + 4][0], v[8 * j + 5][0]); x0.w = pg8::cvt_pk_bf16(v[8 * j + 6][0], v[8 * j + 7][0]);
        x1.x = pg8::cvt_pk_bf16(v[8 * j][1], v[8 * j + 1][1]); x1.y = pg8::cvt_pk_bf16(v[8 * j + 2][1], v[8 * j + 3][1]); x1.z = pg8::cvt_pk_bf16(v[8 * j + 4][1], v[8 * j + 5][1]); x1.w = pg8::cvt_pk_bf16(v[8 * j + 6][1], v[8 * j + 7][1]);
        *(v4u*)(o0 + 8 * j) = x0; *(v4u*)(o1 + 8 * j) = x1; }
}
__device__ __forceinline__ void convert_range(int lo, int hi, int first, int stride, const Args& a, unsigned char* ws, LAS float* scr, int lane) {
#pragma unroll 1
    for (int r = lo + first; r < hi; r += stride) { Item it; decode_item(r, a, ws, it); item_convert(it, lane); }
}

template <bool KNORM>
__device__ __forceinline__ void attn_block(const bf16* K, const bf16* V, int ld, int limit, float q0, float q1, float& m, float& l, float& o0, float& o1, LAS float* sc, int lane) {
    float bm = -1e30f;
    limit = __builtin_amdgcn_readfirstlane(limit);
    for (int key = 0; key < limit; ++key) {
        const unsigned kk = *(const unsigned*)(K + (size_t)key * ld + 2 * lane);
        const float k0 = bflo(kk), k1 = bfhi(kk);
        float s = wave_sum(q0 * k0 + q1 * k1);
        if (KNORM) { const float ss = wave_sum(k0 * k0 + k1 * k1); s *= rsqrtf(ss * (1.0f / 128.0f) + EPS); }
        if (lane == 0) sc[key] = s;
        bm = fmaxf(bm, s);
    }
    const float mn = fmaxf(m, bm), corr = __expf(m - mn);
    l *= corr; o0 *= corr; o1 *= corr;
    LDS_WAIT();
    for (int key = 0; key < limit; ++key) {
        const float p = __expf(sc[key] - mn); l += p;
        const unsigned vv = *(const unsigned*)(V + (size_t)key * ld + 2 * lane);
        o0 += p * bflo(vv); o1 += p * bfhi(vv);
    }
    LDS_WAIT();
    m = mn;
}

typedef short bf16x8_t __attribute__((ext_vector_type(8)));
constexpr int KTS = 72, QS = 136;
constexpr size_t WS_UPDT = WS_W1GU, WS_SPT = WS_XN, WS_DEC = WS_KMEAN + 512 * 1024;
__device__ __forceinline__ float logsig(float x) { return fminf(x, 0.f) - log1pf(__expf(-fabsf(x))); }
__device__ __forceinline__ void load_vt(const bf16* U, size_t row0, int vcol, LAS bf16* VTw, int lane) {
    const v4u* p = (const v4u*)(U + (row0 + lane) * NINP + vcol);
#pragma unroll
    for (int c = 0; c < 4; ++c) { const v4u x = p[c]; const unsigned w[4] = {x.x, x.y, x.z, x.w};
#pragma unroll
        for (int e = 0; e < 4; ++e) { VTw[(c * 8 + 2 * e) * KTS + lane] = (bf16)(w[e] & 0xffffu); VTw[(c * 8 + 2 * e + 1) * KTS + lane] = (bf16)(w[e] >> 16); } }
}
__device__ __forceinline__ void gla_a(int task, const bf16* U, const float* LR, const float* w2, const float* b2, float* BCUM, float* DEC, float* UPDT, LAS unsigned char* lds, int tid) {
    const int lane = tid & 63, wave = tid >> 6, l15 = lane & 15, lq = lane >> 4;
    const int bh = task >> 6, n = task & 63, b = bh >> 2, h = bh & 3; const size_t row0 = (size_t)b * T_ + n * 64;
    LAS bf16* KT = (LAS bf16*)lds;
    LAS float* segtot = (LAS float*)(lds + 18432);
    LAS bf16* VTw = (LAS bf16*)(lds + 20480 + wave * 4608);
    const int d = tid & 127, ig = tid >> 7;
    float w2c[16];
#pragma unroll
    for (int j = 0; j < 16; ++j) w2c[j] = w2[j * 512 + h * 128 + d];
    const float bias = b2[h * 128 + d];
    float c[16]; float run = 0.f;
#pragma unroll
    for (int ii = 0; ii < 16; ++ii) { const f32x4* lr = (const f32x4*)(LR + (row0 + ig * 16 + ii) * 16); float acc = bias;
#pragma unroll
        for (int j4 = 0; j4 < 4; ++j4) { const f32x4 v = lr[j4]; acc += v[0] * w2c[4 * j4] + v[1] * w2c[4 * j4 + 1] + v[2] * w2c[4 * j4 + 2] + v[3] * w2c[4 * j4 + 3]; }
        run += logsig(acc) * (1.0f / 16.0f); c[ii] = run; }
    segtot[ig * 128 + d] = run;
    load_vt(U, row0, GV_OFF + h * 256 + 32 * wave, VTw, lane);
    __syncthreads();
    const float s0 = segtot[d], s1 = segtot[128 + d], s2 = segtot[256 + d], s3 = segtot[384 + d];
    const float pre = ((ig > 0 ? s0 : 0.f) + (ig > 1 ? s1 : 0.f)) + (ig > 2 ? s2 : 0.f), blast = ((s0 + s1) + s2) + s3;
    unsigned short kraw[16];
#pragma unroll
    for (int ii = 0; ii < 16; ++ii) kraw[ii] = U[(row0 + ig * 16 + ii) * NINP + GK_OFF + h * 128 + d];
    asm volatile("" ::: "memory");
    unsigned pk[8];
#pragma unroll
    for (int ii = 0; ii < 16; ii += 2) { float kt[2];
#pragma unroll
        for (int e = 0; e < 2; ++e) { const size_t row = row0 + ig * 16 + ii + e; const float bc = pre + c[ii + e];
            BCUM[row * 512 + h * 128 + d] = bc;
            kt[e] = bflo((unsigned)kraw[ii + e]) * __expf(blast - bc); }
        pk[ii >> 1] = pk2(kt[0], kt[1]); }
    *(LAS v4u*)(KT + d * KTS + ig * 16) = (v4u){pk[0], pk[1], pk[2], pk[3]};
    *(LAS v4u*)(KT + d * KTS + ig * 16 + 8) = (v4u){pk[4], pk[5], pk[6], pk[7]};
    if (ig == 0) DEC[(size_t)task * 128 + d] = __expf(blast);
    __syncthreads();
    f32x4 acc[8][2];
#pragma unroll
    for (int dt = 0; dt < 8; ++dt) { acc[dt][0] = (f32x4){0.f, 0.f, 0.f, 0.f}; acc[dt][1] = (f32x4){0.f, 0.f, 0.f, 0.f}; }
#pragma unroll
    for (int ks = 0; ks < 2; ++ks) {
        const bf16x8_t B0 = *(const LAS bf16x8_t*)(VTw + (l15) * KTS + ks * 32 + 8 * lq), B1 = *(const LAS bf16x8_t*)(VTw + (16 + l15) * KTS + ks * 32 + 8 * lq);
#pragma unroll
        for (int dt = 0; dt < 8; ++dt) { const bf16x8_t A = *(const LAS bf16x8_t*)(KT + (dt * 16 + l15) * KTS + ks * 32 + 8 * lq);
            acc[dt][0] = __builtin_amdgcn_mfma_f32_16x16x32_bf16(A, B0, acc[dt][0], 0, 0, 0); acc[dt][1] = __builtin_amdgcn_mfma_f32_16x16x32_bf16(A, B1, acc[dt][1], 0, 0, 0); } }
    float* up = UPDT + (size_t)task * 32768;
#pragma unroll
    for (int dt = 0; dt < 8; ++dt)
#pragma unroll
        for (int nt = 0; nt < 2; ++nt) *(f32x4*)(up + (32 * wave + nt * 16 + l15) * 128 + dt * 16 + lq * 4) = acc[dt][nt];
    __syncthreads();
}
__device__ __forceinline__ void gla_scan(int idx, const float* __restrict__ UPDT, const float* __restrict__ DEC, bf16* __restrict__ SPT) {
    const int d4 = idx & 31, v = (idx >> 5) & 255, bh = idx >> 13;
    f32x4 S = (f32x4){0.f, 0.f, 0.f, 0.f};
    const size_t e0 = (size_t)v * 128 + d4 * 4;
#pragma unroll 1
    for (int n0 = 0; n0 < 64; n0 += 16) {
        f32x4 u[16], dc[16];
#pragma unroll
        for (int j = 0; j < 16; ++j) { const size_t task = (size_t)bh * 64 + n0 + j; u[j] = *(const f32x4*)(UPDT + task * 32768 + e0); dc[j] = *(const f32x4*)(DEC + task * 128 + d4 * 4); }
        asm volatile("" ::: "memory");
#pragma unroll
        for (int j = 0; j < 16; ++j) { const size_t task = (size_t)bh * 64 + n0 + j;
            v2u pk; pk.x = pg8::cvt_pk_bf16(S[0], S[1]); pk.y = pg8::cvt_pk_bf16(S[2], S[3]); *(v2u*)(SPT + task * 32768 + e0) = pk;
            S = dc[j] * S + u[j]; }
    }
}
__device__ __forceinline__ void gla_c(int task, const bf16* U, const float* BCUM, const bf16* SPT, const float* gout, bf16* MIX, LAS unsigned char* lds, int tid) {
    const int lane = tid & 63, wave = tid >> 6, l15 = lane & 15, lq = lane >> 4;
    const int bh = task >> 6, n = task & 63, b = bh >> 2, h = bh & 3; const size_t row0 = (size_t)b * T_ + n * 64;
    LAS bf16* QD = (LAS bf16*)lds;
    LAS bf16* KI = (LAS bf16*)(lds + 17408);
    LAS bf16* ATT = (LAS bf16*)(lds + 34816);
    LAS float* SSQ = (LAS float*)(lds + 44032);
    LAS bf16* VTw = (LAS bf16*)(lds + 46080 + wave * 4608);
    const int d = tid & 127, ig = tid >> 7;
    { v4u q8[2], k8[2]; f32x4 bc0[2], bc1[2];
#pragma unroll
      for (int rep = 0; rep < 2; ++rep) { const int idx = tid + NTHR * rep, i = idx >> 4, c8 = (idx & 15) * 8; const size_t row = row0 + i;
          q8[rep] = *(const v4u*)(U + row * NINP + GQ_OFF + h * 128 + c8); k8[rep] = *(const v4u*)(U + row * NINP + GK_OFF + h * 128 + c8);
          bc0[rep] = *(const f32x4*)(BCUM + row * 512 + h * 128 + c8); bc1[rep] = *(const f32x4*)(BCUM + row * 512 + h * 128 + c8 + 4); }
#pragma unroll
      for (int rep = 0; rep < 2; ++rep) { const int idx = tid + NTHR * rep, i = idx >> 4, c8 = (idx & 15) * 8;
          const float bc[8] = {bc0[rep][0], bc0[rep][1], bc0[rep][2], bc0[rep][3], bc1[rep][0], bc1[rep][1], bc1[rep][2], bc1[rep][3]};
          const unsigned qw[4] = {q8[rep].x, q8[rep].y, q8[rep].z, q8[rep].w}, kw[4] = {k8[rep].x, k8[rep].y, k8[rep].z, k8[rep].w};
          unsigned qo[4], ko[4];
#pragma unroll
          for (int e = 0; e < 4; ++e) { const float e0 = __expf(bc[2 * e]), e1 = __expf(bc[2 * e + 1]);
              qo[e] = pg8::cvt_pk_bf16(bflo(qw[e]) * 0.08838834764831845f * e0, bfhi(qw[e]) * 0.08838834764831845f * e1);
              ko[e] = pg8::cvt_pk_bf16(bflo(kw[e]) * __builtin_amdgcn_rcpf(e0), bfhi(kw[e]) * __builtin_amdgcn_rcpf(e1)); }
          *(LAS v4u*)(QD + i * QS + c8) = (v4u){qo[0], qo[1], qo[2], qo[3]}; *(LAS v4u*)(KI + i * QS + c8) = (v4u){ko[0], ko[1], ko[2], ko[3]}; } }
    load_vt(U, row0, GV_OFF + h * 256 + 32 * wave, VTw, lane);
    bf16x8_t sp[2][4];
#pragma unroll
    for (int vt = 0; vt < 2; ++vt)
#pragma unroll
        for (int ks = 0; ks < 4; ++ks) sp[vt][ks] = *(const bf16x8_t*)(SPT + (size_t)task * 32768 + (32 * wave + vt * 16 + l15) * 128 + ks * 32 + 8 * lq);
    v2u rr8[4][2];
#pragma unroll
    for (int it = 0; it < 4; ++it)
#pragma unroll
        for (int vt = 0; vt < 2; ++vt) rr8[it][vt] = *(const v2u*)(U + (row0 + it * 16 + l15) * NINP + GR_OFF + h * 256 + 32 * wave + vt * 16 + lq * 4);
    __syncthreads();
#pragma unroll
    for (int tt = 0; tt < 2; ++tt) { const int tile = 2 * wave + tt, it = tile >> 2, jt = tile & 3;
        f32x4 sv = (f32x4){0.f, 0.f, 0.f, 0.f};
        if (jt <= it) {
#pragma unroll
            for (int ks = 0; ks < 4; ++ks) { const bf16x8_t A = *(const LAS bf16x8_t*)(KI + (jt * 16 + l15) * QS + ks * 32 + 8 * lq), B = *(const LAS bf16x8_t*)(QD + (it * 16 + l15) * QS + ks * 32 + 8 * lq);
                sv = __builtin_amdgcn_mfma_f32_16x16x32_bf16(A, B, sv, 0, 0, 0); } }
        const int i = it * 16 + l15, j0 = jt * 16 + lq * 4;
#pragma unroll
        for (int r = 0; r < 4; ++r) if (j0 + r > i) sv[r] = 0.f;
        v2u pk; pk.x = pk2(sv[0], sv[1]); pk.y = pk2(sv[2], sv[3]);
        *(LAS v2u*)(ATT + i * KTS + j0) = pk; }
    __syncthreads();
    f32x4 acc[2][4];
#pragma unroll
    for (int it = 0; it < 4; ++it) { acc[0][it] = (f32x4){0.f, 0.f, 0.f, 0.f}; acc[1][it] = (f32x4){0.f, 0.f, 0.f, 0.f};
#pragma unroll
        for (int ks = 0; ks < 4; ++ks) { const bf16x8_t B = *(const LAS bf16x8_t*)(QD + (it * 16 + l15) * QS + ks * 32 + 8 * lq);
            acc[0][it] = __builtin_amdgcn_mfma_f32_16x16x32_bf16(sp[0][ks], B, acc[0][it], 0, 0, 0); acc[1][it] = __builtin_amdgcn_mfma_f32_16x16x32_bf16(sp[1][ks], B, acc[1][it], 0, 0, 0); }
#pragma unroll
        for (int ks = 0; ks < 2; ++ks) { const bf16x8_t B = *(const LAS bf16x8_t*)(ATT + (it * 16 + l15) * KTS + ks * 32 + 8 * lq);
            const bf16x8_t A0 = *(const LAS bf16x8_t*)(VTw + (l15) * KTS + ks * 32 + 8 * lq), A1 = *(const LAS bf16x8_t*)(VTw + (16 + l15) * KTS + ks * 32 + 8 * lq);
            acc[0][it] = __builtin_amdgcn_mfma_f32_16x16x32_bf16(A0, B, acc[0][it], 0, 0, 0); acc[1][it] = __builtin_amdgcn_mfma_f32_16x16x32_bf16(A1, B, acc[1][it], 0, 0, 0); } }
#pragma unroll
    for (int it = 0; it < 4; ++it) { float ssq = 0.f;
#pragma unroll
        for (int vt = 0; vt < 2; ++vt) { const f32x4 x = acc[vt][it]; ssq += (x[0] * x[0] + x[1] * x[1]) + (x[2] * x[2] + x[3] * x[3]); }
        ssq += __shfl_xor(ssq, 16); ssq += __shfl_xor(ssq, 32);
        if (lq == 0) SSQ[wave * 64 + it * 16 + l15] = ssq; }
    __syncthreads();
#pragma unroll
    for (int it = 0; it < 4; ++it) { const int i = it * 16 + l15; float tot = 0.f;
#pragma unroll
        for (int w = 0; w < 8; ++w) tot += SSQ[w * 64 + i];
        const float rinv = rsqrtf(tot * (1.0f / 256.0f) + EPS); const size_t row = row0 + i;
#pragma unroll
        for (int vt = 0; vt < 2; ++vt) { const int v = 32 * wave + vt * 16 + lq * 4;
            const v2u rr = rr8[it][vt]; const f32x4 g = *(const f32x4*)(gout + v); const f32x4 x = acc[vt][it];
            v2u pk; pk.x = pk2(x[0] * rinv * g[0] * pg8::silu_f(bflo(rr.x)), x[1] * rinv * g[1] * pg8::silu_f(bfhi(rr.x)));
            pk.y = pk2(x[2] * rinv * g[2] * pg8::silu_f(bflo(rr.y)), x[3] * rinv * g[3] * pg8::silu_f(bfhi(rr.y)));
            *(v2u*)(MIX + row * D_ + h * 256 + v) = pk; } }
    __syncthreads();
}

__global__ void __launch_bounds__(NTHR, 2) hymba_fwd(Args a) {
    extern __shared__ __attribute__((aligned(16))) unsigned char lds_raw[];
    LAS unsigned char* lds = (LAS unsigned char*)lds_raw;
    cg::grid_group grid = cg::this_grid();
    const int tid = threadIdx.x, lane = tid & 63, wave = __builtin_amdgcn_readfirstlane(tid >> 6);
    const int G = gridDim.x, gw = blockIdx.x * NWAVES + wave, NGW = G * NWAVES;
    unsigned char* ws = a.ws;
    volatile LAS unsigned* xst = (volatile LAS unsigned*)(lds + LDS_BYTES - 64);
    if (tid < 16) xst[tid] = 0u;
    __syncthreads();
    const XcdBarrier bar = xcd_barrier_post((unsigned*)ws, xst);
    const float* x = a.in[0]; float* out = a.out;
    bf16 *W1GU = (bf16*)(ws + WS_W1GU), *W1D = (bf16*)(ws + WS_W1D), *W2GU = (bf16*)(ws + WS_W2GU), *W2D = (bf16*)(ws + WS_W2D), *WIN = (bf16*)(ws + WS_WIN),
         *WOUT = (bf16*)(ws + WS_WOUT), *WQ = (bf16*)(ws + WS_WQ), *WKV = (bf16*)(ws + WS_WKV), *WO = (bf16*)(ws + WS_WO);
    bf16 *XN = (bf16*)(ws + WS_XN), *MEMN = (bf16*)(ws + WS_MEMN), *ACT = (bf16*)(ws + WS_ACT), *U = (bf16*)(ws + WS_ACT), *XQ = (bf16*)(ws + WS_XQ), *XO = (bf16*)(ws + WS_XO),
         *MKV = (bf16*)(ws + WS_MKV), *MIX = (bf16*)(ws + WS_MIX);
    float *SS = (float*)(ws + WS_SS), *ORAW = (float*)(ws + WS_XN), *LR = (float*)(ws + WS_LR), *LA = (float*)(ws + WS_LA), *KMEAN = (float*)(ws + WS_KMEAN);
    float *UPDT = (float*)(ws + WS_UPDT), *DEC = (float*)(ws + WS_DEC); bf16* SPT = (bf16*)(ws + WS_SPT);
#define IN(k) (a.lo1 <= (k) && (k) < a.hi1)
#define SEAM(k) do { if (a.lo1 <= (k) && (k) < a.hi1 && ((k) + 1 < a.hi1 || a.lo2 < a.hi2)) { if (a.hi2 < 0) grid.sync(); else xcd_barrier(bar); } } while (0)

    if (IN(0)) {
        LAS float* scr = (LAS float*)(lds + wave * 16384);
        convert_range(IL_W1GU, IL_W1D, gw, NGW, a, ws, scr, lane);
        if (gw >= 768) convert_range(IL_WOUT, IL_W2GU, gw - 768, NGW - 768, a, ws, scr, lane);
        const float* g1 = a.in[2];
        for (int m = gw; m < M_; m += NGW) {
            const f32x4* xr = (const f32x4*)(x + (size_t)m * D_) + lane; f32x4 v[8]; float ss = 0.f;
#pragma unroll
            for (int j = 0; j < 8; ++j) { v[j] = xr[64 * j]; ss += (v[j][0] * v[j][0] + v[j][1] * v[j][1]) + (v[j][2] * v[j][2] + v[j][3] * v[j][3]); }
            ss = wave_sum(ss);
#pragma unroll
            for (int j = 0; j < 8; ++j) { const f32x4 gv = ((const f32x4*)g1)[lane + 64 * j]; const f32x4 w = v[j] * gv; v2u pk; pk.x = pk2(w[0], w[1]); pk.y = pk2(w[2], w[3]);
                *(v2u*)(XN + (size_t)m * D_ + 4 * lane + 256 * j) = pk; }
            if (lane < 32) SS[(size_t)m * 32 + lane] = (lane == 0) ? ss : 0.f;
        }
        const float* gm = a.in[15]; const float* mem = a.in[1];
        for (int m = gw; m < MM_; m += NGW) {
            const f32x4* xr = (const f32x4*)(mem + (size_t)m * D_) + lane; f32x4 v[8]; float ss = 0.f;
#pragma unroll
            for (int j = 0; j < 8; ++j) { v[j] = xr[64 * j]; ss += (v[j][0] * v[j][0] + v[j][1] * v[j][1]) + (v[j][2] * v[j][2] + v[j][3] * v[j][3]); }
            const float rs = rsqrtf(wave_sum(ss) * (1.0f / D_) + EPS);
#pragma unroll
            for (int j = 0; j < 8; ++j) { const f32x4 gv = ((const f32x4*)gm)[lane + 64 * j]; const f32x4 w = v[j] * gv * rs; v2u pk; pk.x = pk2(w[0], w[1]); pk.y = pk2(w[2], w[3]);
                *(v2u*)(MEMN + (size_t)m * D_ + 4 * lane + 256 * j) = pk; }
        }
        __syncthreads();
    }
    SEAM(0);
#ifdef PROBE_SYNCS
    for (int i_ = 0; i_ < PROBE_SYNCS; ++i_) xcd_barrier(bar);
#endif
    if (IN(1)) {
        pg8::Gemm g{XN, W1GU, M_, NGU, D_}; pg8::StaticOrder S; S.init(M_, NGU, G, (int)blockIdx.x);
        pg8::EpiSwiGLU E{ACT, FF_, SS};
        pg8::gemm_phase<pg8::EpiSwiGLU, pg8::StaticOrder, true, true>(lds, g, S, E);
        if ((int)blockIdx.x >= 128) convert_range(IL_W1D, IL_WOUT, ((int)blockIdx.x - 128) * NWAVES + wave, (G - 128) * NWAVES, a, ws, (LAS float*)(lds + wave * 16384), lane);
    }
    SEAM(1);
    if (IN(2)) {
        pg8::Gemm g{ACT, W1D, M_, D_, FF_}; pg8::StaticOrder S; S.init(M_, D_, G, (int)blockIdx.x);
        pg8::EpiResid E{x, out, D_, 0.5f, XN, a.in[6], SS};
        pg8::gemm_phase<pg8::EpiResid, pg8::StaticOrder, true, true>(lds, g, S, E);
    }
    SEAM(2);
    if (IN(3)) {
        pg8::Gemm g{XN, WIN, M_, NU, D_}; pg8::StaticOrder S; S.init(M_, NU, G, (int)blockIdx.x);
        pg8::EpiScale<false> E{U, NINP, SS, nullptr};
        pg8::gemm_phase<pg8::EpiScale<false>, pg8::StaticOrder, true, true>(lds, g, S, E);
        {
            const bf16* WLR = WIN + (size_t)NU * D_; const int l15 = lane & 15, lq = lane >> 4;
            LAS float* lrp = (LAS float*)lds;
            LAS float* rsl = (LAS float*)(lds + 16384);
            for (int rb = blockIdx.x; rb < M_ / 32; rb += G) { const size_t row0 = (size_t)rb * 32;
                f32x4 la[2] = {(f32x4){0.f, 0.f, 0.f, 0.f}, (f32x4){0.f, 0.f, 0.f, 0.f}};
#pragma unroll
                for (int half = 0; half < 2; ++half) { bf16x8_t Bf[4], Af[4][2];
#pragma unroll
                    for (int kk = 0; kk < 4; ++kk) { const int ko = (wave * 8 + half * 4 + kk) * 32 + 8 * lq;
                        Bf[kk] = *(const bf16x8_t*)(WLR + (size_t)l15 * D_ + ko);
#pragma unroll
                        for (int mt = 0; mt < 2; ++mt) Af[kk][mt] = *(const bf16x8_t*)(XN + (row0 + mt * 16 + l15) * D_ + ko); }
                    asm volatile("" ::: "memory");
#pragma unroll
                    for (int kk = 0; kk < 4; ++kk)
#pragma unroll
                        for (int mt = 0; mt < 2; ++mt) la[mt] = __builtin_amdgcn_mfma_f32_16x16x32_bf16(Af[kk][mt], Bf[kk], la[mt], 0, 0, 0); }
#pragma unroll
                for (int mt = 0; mt < 2; ++mt)
#pragma unroll
                    for (int r = 0; r < 4; ++r) lrp[wave * 512 + (mt * 16 + lq * 4 + r) * 16 + l15] = la[mt][r];
                if (tid < 32) { const f32x4* sp = (const f32x4*)(SS + (row0 + tid) * 32); float t = 0.f;
#pragma unroll
                    for (int j = 0; j < 8; ++j) { const f32x4 v = sp[j]; t += (v[0] + v[1]) + (v[2] + v[3]); }
                    rsl[tid] = rsqrtf(t * (1.0f / D_) + EPS); }
                __syncthreads();
                { float t = 0.f;
#pragma unroll
                  for (int w = 0; w < 8; ++w) t += lrp[w * 512 + tid];
                  LR[row0 * 16 + tid] = t * rsl[tid >> 4]; }
                __syncthreads(); }
        }
    }
    SEAM(3);
    if (IN(4)) {
        const float* w2 = a.in[8]; const float* b2 = a.in[9];
        if (!ANCHOR_GLA) { for (int task = blockIdx.x; task < 512; task += G) gla_a(task, U, LR, w2, b2, LA, DEC, UPDT, lds, tid); }
        if (ANCHOR_GLA) for (int idx = blockIdx.x * NTHR + tid; idx < M_ * 512; idx += G * NTHR) {
            const int row = idx >> 9, c = idx & 511; const float* lr = LR + (size_t)row * 16; float acc = b2[c];
#pragma unroll
            for (int j = 0; j < 16; ++j) acc += lr[j] * w2[j * 512 + c];
            const float ls = fminf(acc, 0.f) - log1pf(__expf(-fabsf(acc)));
            LA[idx] = ls * (1.0f / 16.0f);
        }
        const float* gq = a.in[11]; const float* gk = a.in[12];
        const int e8 = (lane & 15) * 8, sub = lane >> 4;
        f32x4 gq0 = *(const f32x4*)(gq + e8), gq1 = *(const f32x4*)(gq + e8 + 4), gk0 = *(const f32x4*)(gk + e8), gk1 = *(const f32x4*)(gk + e8 + 4);
        v4u qv[4][2];
#pragma unroll
        for (int rr = 0; rr < 4; ++rr)
#pragma unroll
            for (int j = 0; j < 2; ++j) qv[rr][j] = *(const v4u*)(U + (size_t)(gw + rr * NGW) * NINP + MQ_OFF + (sub + 4 * j) * 128 + e8);
        asm volatile("" ::: "memory");
#pragma unroll
        for (int rr = 0; rr < 4; ++rr) { const int row = gw + rr * NGW;
#pragma unroll
            for (int j = 0; j < 2; ++j) { const int hh = sub + 4 * j; bf16* p = U + (size_t)row * NINP + MQ_OFF + hh * 128 + e8;
                const v4u r = qv[rr][j]; float f[8] = {bflo(r.x), bfhi(r.x), bflo(r.y), bfhi(r.y), bflo(r.z), bfhi(r.z), bflo(r.w), bfhi(r.w)};
                float ss = 0.f;
#pragma unroll
                for (int i = 0; i < 8; ++i) ss += f[i] * f[i];
                ss += __shfl_xor(ss, 1); ss += __shfl_xor(ss, 2); ss += __shfl_xor(ss, 4); ss += __shfl_xor(ss, 8);
                const float rs = rsqrtf(ss * (1.0f / 128.0f) + EPS);
                v4u o; o.x = pk2(f[0] * rs * gq0[0], f[1] * rs * gq0[1]); o.y = pk2(f[2] * rs * gq0[2], f[3] * rs * gq0[3]); o.z = pk2(f[4] * rs * gq1[0], f[5] * rs * gq1[1]); o.w = pk2(f[6] * rs * gq1[2], f[7] * rs * gq1[3]);
                *(v4u*)p = o; }
        }
        for (int task = blockIdx.x; task < B_ * 8 * 16; task += G) {
            const int b = task >> 7, h = (task >> 4) & 7, blk = task & 15; float ms[8] = {0.f, 0.f, 0.f, 0.f, 0.f, 0.f, 0.f, 0.f};
            bf16* p0 = U + (size_t)(b * T_ + blk * 256 + 32 * wave + sub) * NINP + MK_OFF + h * 128 + e8;
            v4u rv[8];
#pragma unroll
            for (int it = 0; it < 8; ++it) rv[it] = *(const v4u*)(p0 + (size_t)(it * 4) * NINP);
            asm volatile("" ::: "memory");
#pragma unroll
            for (int it = 0; it < 8; ++it) { const v4u r = rv[it]; float f[8] = {bflo(r.x), bfhi(r.x), bflo(r.y), bfhi(r.y), bflo(r.z), bfhi(r.z), bflo(r.w), bfhi(r.w)};
                float ss = 0.f;
#pragma unroll
                for (int i = 0; i < 8; ++i) ss += f[i] * f[i];
                ss += __shfl_xor(ss, 1); ss += __shfl_xor(ss, 2); ss += __shfl_xor(ss, 4); ss += __shfl_xor(ss, 8);
                const float rs = rsqrtf(ss * (1.0f / 128.0f) + EPS);
                f[0] *= rs * gk0[0]; f[1] *= rs * gk0[1]; f[2] *= rs * gk0[2]; f[3] *= rs * gk0[3]; f[4] *= rs * gk1[0]; f[5] *= rs * gk1[1]; f[6] *= rs * gk1[2]; f[7] *= rs * gk1[3];
#pragma unroll
                for (int i = 0; i < 8; ++i) ms[i] += f[i];
                v4u o; o.x = pk2(f[0], f[1]); o.y = pk2(f[2], f[3]); o.z = pk2(f[4], f[5]); o.w = pk2(f[6], f[7]);
                *(v4u*)(p0 + (size_t)(it * 4) * NINP) = o; }
#pragma unroll
            for (int i = 0; i < 8; ++i) { ms[i] += __shfl_xor(ms[i], 16); ms[i] += __shfl_xor(ms[i], 32); }
            LAS float* part = (LAS float*)lds;
            if (sub == 0) { *(LAS f32x4*)(part + wave * 128 + e8) = (f32x4){ms[0], ms[1], ms[2], ms[3]}; *(LAS f32x4*)(part + wave * 128 + e8 + 4) = (f32x4){ms[4], ms[5], ms[6], ms[7]}; }
            __syncthreads();
            if (tid < 128) { float t = 0.f;
#pragma unroll
                for (int w = 0; w < 8; ++w) t += part[w * 128 + tid];
                KMEAN[(size_t)task * 128 + tid] = t * (1.0f / 256.0f); }
            __syncthreads();
        }
    }
    SEAM(4);
    if (IN(5)) {
        constexpr int NGLA = ANCHOR_GLA ? 16 : 0;
        if (ANCHOR_GLA && (int)blockIdx.x < NGLA) {
            const int bh = blockIdx.x >> 1, b = bh >> 2, h = bh & 3, v = (blockIdx.x & 1) * 128 + (tid >> 2), kp = tid & 3;
            float S[32];
#pragma unroll
            for (int i = 0; i < 32; ++i) S[i] = 0.f;
            for (int t = 0; t < T_; ++t) {
                const size_t row = (size_t)b * T_ + t; const bf16* ur = U + row * NINP;
                const v4u* qp = (const v4u*)(ur + GQ_OFF + h * 128 + kp * 32); const v4u* kpp = (const v4u*)(ur + GK_OFF + h * 128 + kp * 32);
                const f32x4* lap = (const f32x4*)(LA + row * 512 + h * 128 + kp * 32);
                const float vv = bflo((unsigned)ur[GV_OFF + h * 256 + v]);
                float o = 0.f;
#pragma unroll
                for (int i4 = 0; i4 < 4; ++i4) { const v4u qq = qp[i4], kk = kpp[i4]; const f32x4 la0 = lap[2 * i4], la1 = lap[2 * i4 + 1];
                    const float qf[8] = {bflo(qq.x), bfhi(qq.x), bflo(qq.y), bfhi(qq.y), bflo(qq.z), bfhi(qq.z), bflo(qq.w), bfhi(qq.w)};
                    const float kf[8] = {bflo(kk.x), bfhi(kk.x), bflo(kk.y), bfhi(kk.y), bflo(kk.z), bfhi(kk.z), bflo(kk.w), bfhi(kk.w)};
                    const float lf[8] = {la0[0], la0[1], la0[2], la0[3], la1[0], la1[1], la1[2], la1[3]};
#pragma unroll
                    for (int e = 0; e < 8; ++e) { const int i = i4 * 8 + e; S[i] = __expf(lf[e]) * S[i] + kf[e] * vv; o += qf[e] * S[i]; } }
                o *= 0.08838834764831845f;
                o += __shfl_xor(o, 1); o += __shfl_xor(o, 2);
                if (kp == 0) ORAW[row * 1024 + h * 256 + v] = o;
            }
        } else if (!ANCHOR_MOBA) {
            const int p = (int)blockIdx.x - NGLA, pp = p & 127;
            const int bh = pp >> 3, xx = pp & 7, b = bh >> 3, h = bh & 7;
            if (!ANCHOR_GLA && p >= 128 && p < 256) { gla_scan((p - 128) * NTHR + tid, UPDT, DEC, SPT);
                convert_range(IL_W2GU, IL_W2D, (p - 128) * NWAVES + wave, 128 * NWAVES, a, ws, (LAS float*)(lds + wave * 16384), lane); __syncthreads(); }
            if (p < 256) { const bf16* kb = U + (size_t)(b * T_) * NINP + h * 128;
                const int qb = p < 128 ? 15 - xx : xx; const size_t row0 = (size_t)b * T_ + qb * 256;
                att::attn_body<NINP, NINP, D_, 1, 2, (MV_OFF - MK_OFF) * 2, false, true>(U + row0 * NINP + MQ_OFF + h * 128, kb + MK_OFF, MIX + row0 * D_ + 1024 + h * 128, 256 * (qb + 1), (char*)lds_raw,
                                                  nullptr, nullptr, KMEAN + (size_t)(bh * 16) * 128, qb); }
        } else {
            const int nw = (G - NGLA) * NWAVES, w0 = ((int)blockIdx.x - NGLA) * NWAVES + wave;
            LAS float* sc = (LAS float*)(lds + wave * 1024);
            for (int task = w0; task < M_ * 8; task += nw) {
                const int row = task >> 3, h = task & 7, b = row >> 12, t = row & 4095, qblk = t >> 8;
                const unsigned qq = *(const unsigned*)(U + (size_t)row * NINP + MQ_OFF + h * 128 + 2 * lane);
                const float q0 = bflo(qq) * 0.08838834764831845f, q1 = bfhi(qq) * 0.08838834764831845f;
                const float* km = KMEAN + ((size_t)(b * 8 + h) * 16) * 128 + 2 * lane;
                float gt[16];
#pragma unroll
                for (int n = 0; n < 16; ++n) { const f32x2 kv = *(const f32x2*)(km + n * 128); const float d = wave_sum(q0 * kv[0] + q1 * kv[1]); gt[n] = (n < qblk) ? d : -3e38f; }
                unsigned sel = 0;
#pragma unroll
                for (int r = 0; r < 3; ++r) { float best = -3e38f; int bi = -1;
#pragma unroll
                    for (int n = 0; n < 16; ++n) if (gt[n] > best) { best = gt[n]; bi = n; }
                    if (bi >= 0) { sel |= 1u << bi;
#pragma unroll
                        for (int n = 0; n < 16; ++n) if (n == bi) gt[n] = -3e38f; } }
                sel = __builtin_amdgcn_readfirstlane(sel);
                float m = -1e30f, l = 0.f, o0 = 0.f, o1 = 0.f;
                for (int n = 0; n < qblk; ++n) if ((sel >> n) & 1u) { const bf16* kb = U + (size_t)(b * T_ + n * 256) * NINP + h * 128;
                    attn_block<false>(kb + MK_OFF, kb + MV_OFF, NINP, 256, q0, q1, m, l, o0, o1, sc, lane); }
                { const bf16* kb = U + (size_t)(b * T_ + qblk * 256) * NINP + h * 128;
                    attn_block<false>(kb + MK_OFF, kb + MV_OFF, NINP, (t & 255) + 1, q0, q1, m, l, o0, o1, sc, lane); }
                const float il = 1.0f / l;
                *(unsigned*)(MIX + (size_t)row * D_ + 1024 + h * 128 + 2 * lane) = pk2(o0 * il, o1 * il);
            }
        }
    }
    SEAM(5);
    if (IN(6) && !ANCHOR_GLA) { for (int task = blockIdx.x; task < 512; task += G) gla_c(task, U, LA, SPT, a.in[10], MIX, lds, tid); }
    if (IN(6) && ANCHOR_GLA) {
        const float* go = a.in[10]; const f32x4 gv = *(const f32x4*)(go + 4 * lane);
        for (int task = gw; task < M_ * 4; task += NGW) {
            const int row = task >> 2, h = task & 3;
            const f32x4 o = *(const f32x4*)(ORAW + (size_t)row * 1024 + h * 256 + 4 * lane);
            const float ss = wave_sum((o[0] * o[0] + o[1] * o[1]) + (o[2] * o[2] + o[3] * o[3]));
            const float rs = rsqrtf(ss * (1.0f / 256.0f) + EPS);
            const v2u rr = *(const v2u*)(U + (size_t)row * NINP + GR_OFF + h * 256 + 4 * lane);
            const float r0 = bflo(rr.x), r1 = bfhi(rr.x), r2 = bflo(rr.y), r3 = bfhi(rr.y);
            v2u pk; pk.x = pk2(o[0] * rs * gv[0] * pg8::silu_f(r0), o[1] * rs * gv[1] * pg8::silu_f(r1)); pk.y = pk2(o[2] * rs * gv[2] * pg8::silu_f(r2), o[3] * rs * gv[3] * pg8::silu_f(r3));
            *(v2u*)(MIX + (size_t)row * D_ + h * 256 + 4 * lane) = pk;
        }
    }
    SEAM(6);
    if (IN(7)) {
        pg8::Gemm g{MIX, WOUT, M_, D_, D_}; pg8::StaticOrder S; S.init(M_, D_, G, (int)blockIdx.x);
        pg8::EpiResid E{out, out, D_, 1.0f, XN, a.in[14], SS};
        pg8::gemm_phase<pg8::EpiResid, pg8::StaticOrder, true, true>(lds, g, S, E);
    }
    SEAM(7);
    if (IN(8)) {
        { pg8::Gemm g{XN, WQ, M_, 512, D_}; pg8::StaticOrder S; S.init(M_, 512, G, (int)blockIdx.x);
          pg8::EpiScale<false> E{XQ, 512, SS, nullptr};
          pg8::gemm_phase<pg8::EpiScale<false>, pg8::StaticOrder, true, true>(lds, g, S, E); }
        { pg8::Gemm g{MEMN, WKV, MM_, 1024, D_}; pg8::StaticOrder S; S.init(MM_, 1024, G, (G - 1) - (int)blockIdx.x);
          pg8::EpiScale<false> E{MKV, 1024, nullptr, nullptr};
          pg8::gemm_phase<pg8::EpiScale<false>, pg8::StaticOrder, true, true>(lds, g, S, E); }
        if ((int)blockIdx.x >= 64 && (int)blockIdx.x < 248) convert_range(IL_W2D, IL_END, ((int)blockIdx.x - 64) * NWAVES + wave, 184 * NWAVES, a, ws, (LAS float*)(lds + wave * 16384), lane);
    }
    SEAM(8);
    if (IN(9) && !ANCHOR_XATTN) {
        for (int task = blockIdx.x; task < 128; task += G) { const int b = task >> 6, h = (task >> 4) & 3, qt = task & 15; const size_t row0 = (size_t)b * T_ + qt * 256;
            const bf16* kb = MKV + (size_t)(b * MEML) * 1024 + h * 128;
            att::attn_body<512, 1024, 512, 0, 2, 1024, true, false>(XQ + row0 * 512 + h * 128, kb, XO + row0 * 512 + h * 128, MEML, (char*)lds_raw, a.in[19], a.in[20], nullptr, 0); }
    }
    if (IN(9) && ANCHOR_XATTN) {
        const float* gq = a.in[19]; const float* gk = a.in[20];
        const float gg0 = gq[2 * lane] * gk[2 * lane] * 0.08838834764831845f, gg1 = gq[2 * lane + 1] * gk[2 * lane + 1] * 0.08838834764831845f;
        LAS float* sc = (LAS float*)(lds + wave * 1024);
        for (int task = gw; task < M_ * 4; task += NGW) {
            const int row = task >> 2, h = task & 3, b = row >> 12;
            const unsigned qq = *(const unsigned*)(XQ + (size_t)row * 512 + h * 128 + 2 * lane);
            float q0 = bflo(qq), q1 = bfhi(qq);
            const float rs = rsqrtf(wave_sum(q0 * q0 + q1 * q1) * (1.0f / 128.0f) + EPS);
            q0 *= rs * gg0; q1 *= rs * gg1;
            float m = -1e30f, l = 0.f, o0 = 0.f, o1 = 0.f;
            const bf16* kb = MKV + (size_t)(b * MEML) * 1024 + h * 128;
            attn_block<true>(kb, kb + 512, 1024, MEML, q0, q1, m, l, o0, o1, sc, lane);
            const float il = 1.0f / l;
            *(unsigned*)(XO + (size_t)row * 512 + h * 128 + 2 * lane) = pk2(o0 * il, o1 * il);
        }
    }
    SEAM(9);
    if (IN(10)) {
        pg8::Gemm g{XO, WO, M_, D_, 512}; pg8::StaticOrder S; S.init(M_, D_, G, (int)blockIdx.x);
        pg8::EpiResid E{out, out, D_, 1.0f, XN, a.in[21], SS};
        pg8::gemm_phase<pg8::EpiResid, pg8::StaticOrder, true, true>(lds, g, S, E);
    }
    SEAM(10);
    if (IN(11)) {
        pg8::Gemm g{XN, W2GU, M_, NGU, D_}; pg8::StaticOrder S; S.init(M_, NGU, G, (int)blockIdx.x);
        pg8::EpiSwiGLU E{ACT, FF_, SS};
        pg8::gemm_phase<pg8::EpiSwiGLU, pg8::StaticOrder, true, true>(lds, g, S, E);
    }
    SEAM(11);
    if (IN(12)) {
        pg8::Gemm g{ACT, W2D, M_, D_, FF_}; pg8::StaticOrder S; S.init(M_, D_, G, (int)blockIdx.x);
        pg8::EpiResid E{out, out, D_, 0.5f, nullptr, nullptr, nullptr};
        pg8::gemm_phase<pg8::EpiResid, pg8::StaticOrder, true, true>(lds, g, S, E);
    }
#undef IN
#undef SEAM
#ifdef PROBE_REP
#define IN(k) (a.lo2 <= (k) && (k) < a.hi2)
#define SEAM(k) do { if (a.lo2 <= (k) && (k) + 1 < a.hi2) xcd_barrier(bar); } while (0)

    if (IN(0)) {
        LAS float* scr = (LAS float*)(lds + wave * 16384);
        convert_range(IL_W1GU, IL_W1D, gw, NGW, a, ws, scr, lane);
        if (gw >= 768) convert_range(IL_WOUT, IL_W2GU, gw - 768, NGW - 768, a, ws, scr, lane);
        const float* g1 = a.in[2];
        for (int m = gw; m < M_; m += NGW) {
            const f32x4* xr = (const f32x4*)(x + (size_t)m * D_) + lane; f32x4 v[8]; float ss = 0.f;
#pragma unroll
            for (int j = 0; j < 8; ++j) { v[j] = xr[64 * j]; ss += (v[j][0] * v[j][0] + v[j][1] * v[j][1]) + (v[j][2] * v[j][2] + v[j][3] * v[j][3]); }
            ss = wave_sum(ss);
#pragma unroll
            for (int j = 0; j < 8; ++j) { const f32x4 gv = ((const f32x4*)g1)[lane + 64 * j]; const f32x4 w = v[j] * gv; v2u pk; pk.x = pk2(w[0], w[1]); pk.y = pk2(w[2], w[3]);
                *(v2u*)(XN + (size_t)m * D_ + 4 * lane + 256 * j) = pk; }
            if (lane < 32) SS[(size_t)m * 32 + lane] = (lane == 0) ? ss : 0.f;
        }
        const float* gm = a.in[15]; const float* mem = a.in[1];
        for (int m = gw; m < MM_; m += NGW) {
            const f32x4* xr = (const f32x4*)(mem + (size_t)m * D_) + lane; f32x4 v[8]; float ss = 0.f;
#pragma unroll
            for (int j = 0; j < 8; ++j) { v[j] = xr[64 * j]; ss += (v[j][0] * v[j][0] + v[j][1] * v[j][1]) + (v[j][2] * v[j][2] + v[j][3] * v[j][3]); }
            const float rs = rsqrtf(wave_sum(ss) * (1.0f / D_) + EPS);
#pragma unroll
            for (int j = 0; j < 8; ++j) { const f32x4 gv = ((const f32x4*)gm)[lane + 64 * j]; const f32x4 w = v[j] * gv * rs; v2u pk; pk.x = pk2(w[0], w[1]); pk.y = pk2(w[2], w[3]);
                *(v2u*)(MEMN + (size_t)m * D_ + 4 * lane + 256 * j) = pk; }
        }
        __syncthreads();
    }
    SEAM(0);
#ifdef PROBE_SYNCS
    for (int i_ = 0; i_ < PROBE_SYNCS; ++i_) xcd_barrier(bar);
#endif
    if (IN(1)) {
        pg8::Gemm g{XN, W1GU, M_, NGU, D_}; pg8::StaticOrder S; S.init(M_, NGU, G, (int)blockIdx.x);
        pg8::EpiSwiGLU E{ACT, FF_, SS};
        pg8::gemm_phase<pg8::EpiSwiGLU, pg8::StaticOrder, true, true>(lds, g, S, E);
        if ((int)blockIdx.x >= 128) convert_range(IL_W1D, IL_WOUT, ((int)blockIdx.x - 128) * NWAVES + wave, (G - 128) * NWAVES, a, ws, (LAS float*)(lds + wave * 16384), lane);
    }
    SEAM(1);
    if (IN(2)) {
        pg8::Gemm g{ACT, W1D, M_, D_, FF_}; pg8::StaticOrder S; S.init(M_, D_, G, (int)blockIdx.x);
        pg8::EpiResid E{x, out, D_, 0.5f, XN, a.in[6], SS};
        pg8::gemm_phase<pg8::EpiResid, pg8::StaticOrder, true, true>(lds, g, S, E);
    }
    SEAM(2);
    if (IN(3)) {
        pg8::Gemm g{XN, WIN, M_, NU, D_}; pg8::StaticOrder S; S.init(M_, NU, G, (int)blockIdx.x);
        pg8::EpiScale<false> E{U, NINP, SS, nullptr};
        pg8::gemm_phase<pg8::EpiScale<false>, pg8::StaticOrder, true, true>(lds, g, S, E);
        {
            const bf16* WLR = WIN + (size_t)NU * D_; const int l15 = lane & 15, lq = lane >> 4;
            LAS float* lrp = (LAS float*)lds;
            LAS float* rsl = (LAS float*)(lds + 16384);
            for (int rb = blockIdx.x; rb < M_ / 32; rb += G) { const size_t row0 = (size_t)rb * 32;
                f32x4 la[2] = {(f32x4){0.f, 0.f, 0.f, 0.f}, (f32x4){0.f, 0.f, 0.f, 0.f}};
#pragma unroll
                for (int half = 0; half < 2; ++half) { bf16x8_t Bf[4], Af[4][2];
#pragma unroll
                    for (int kk = 0; kk < 4; ++kk) { const int ko = (wave * 8 + half * 4 + kk) * 32 + 8 * lq;
                        Bf[kk] = *(const bf16x8_t*)(WLR + (size_t)l15 * D_ + ko);
#pragma unroll
                        for (int mt = 0; mt < 2; ++mt) Af[kk][mt] = *(const bf16x8_t*)(XN + (row0 + mt * 16 + l15) * D_ + ko); }
                    asm volatile("" ::: "memory");
#pragma unroll
                    for (int kk = 0; kk < 4; ++kk)
#pragma unroll
                        for (int mt = 0; mt < 2; ++mt) la[mt] = __builtin_amdgcn_mfma_f32_16x16x32_bf16(Af[kk][mt], Bf[kk], la[mt], 0, 0, 0); }
#pragma unroll
                for (int mt = 0; mt < 2; ++mt)
#pragma unroll
                    for (int r = 0; r < 4; ++r) lrp[wave * 512 + (mt * 16 + lq * 4 + r) * 16 + l15] = la[mt][r];
                if (tid < 32) { const f32x4* sp = (const f32x4*)(SS + (row0 + tid) * 32); float t = 0.f;
#pragma unroll
                    for (int j = 0; j < 8; ++j) { const f32x4 v = sp[j]; t += (v[0] + v[1]) + (v[2] + v[3]); }
                    rsl[tid] = rsqrtf(t * (1.0f / D_) + EPS); }
                __syncthreads();
                { float t = 0.f;
#pragma unroll
                  for (int w = 0; w < 8; ++w) t += lrp[w * 512 + tid];
                  LR[row0 * 16 + tid] = t * rsl[tid >> 4]; }
                __syncthreads(); }
        }
    }
    SEAM(3);
    if (IN(4)) {
        const float* w2 = a.in[8]; const float* b2 = a.in[9];
        if (!ANCHOR_GLA) { for (int task = blockIdx.x; task < 512; task += G) gla_a(task, U, LR, w2, b2, LA, DEC, UPDT, lds, tid); }
        if (ANCHOR_GLA) for (int idx = blockIdx.x * NTHR + tid; idx < M_ * 512; idx += G * NTHR) {
            const int row = idx >> 9, c = idx & 511; const float* lr = LR + (size_t)row * 16; float acc = b2[c];
#pragma unroll
            for (int j = 0; j < 16; ++j) acc += lr[j] * w2[j * 512 + c];
            const float ls = fminf(acc, 0.f) - log1pf(__expf(-fabsf(acc)));
            LA[idx] = ls * (1.0f / 16.0f);
        }
        const float* gq = a.in[11]; const float* gk = a.in[12];
        const int e8 = (lane & 15) * 8, sub = lane >> 4;
        f32x4 gq0 = *(const f32x4*)(gq + e8), gq1 = *(const f32x4*)(gq + e8 + 4), gk0 = *(const f32x4*)(gk + e8), gk1 = *(const f32x4*)(gk + e8 + 4);
        v4u qv[4][2];
#pragma unroll
        for (int rr = 0; rr < 4; ++rr)
#pragma unroll
            for (int j = 0; j < 2; ++j) qv[rr][j] = *(const v4u*)(U + (size_t)(gw + rr * NGW) * NINP + MQ_OFF + (sub + 4 * j) * 128 + e8);
        asm volatile("" ::: "memory");
#pragma unroll
        for (int rr = 0; rr < 4; ++rr) { const int row = gw + rr * NGW;
#pragma unroll
            for (int j = 0; j < 2; ++j) { const int hh = sub + 4 * j; bf16* p = U + (size_t)row * NINP + MQ_OFF + hh * 128 + e8;
                const v4u r = qv[rr][j]; float f[8] = {bflo(r.x), bfhi(r.x), bflo(r.y), bfhi(r.y), bflo(r.z), bfhi(r.z), bflo(r.w), bfhi(r.w)};
                float ss = 0.f;
#pragma unroll
                for (int i = 0; i < 8; ++i) ss += f[i] * f[i];
                ss += __shfl_xor(ss, 1); ss += __shfl_xor(ss, 2); ss += __shfl_xor(ss, 4); ss += __shfl_xor(ss, 8);
                const float rs = rsqrtf(ss * (1.0f / 128.0f) + EPS);
                v4u o; o.x = pk2(f[0] * rs * gq0[0], f[1] * rs * gq0[1]); o.y = pk2(f[2] * rs * gq0[2], f[3] * rs * gq0[3]); o.z = pk2(f[4] * rs * gq1[0], f[5] * rs * gq1[1]); o.w = pk2(f[6] * rs * gq1[2], f[7] * rs * gq1[3]);
                *(v4u*)p = o; }
        }
        for (int task = blockIdx.x; task < B_ * 8 * 16; task += G) {
            const int b = task >> 7, h = (task >> 4) & 7, blk = task & 15; float ms[8] = {0.f, 0.f, 0.f, 0.f, 0.f, 0.f, 0.f, 0.f};
            bf16* p0 = U + (size_t)(b * T_ + blk * 256 + 32 * wave + sub) * NINP + MK_OFF + h * 128 + e8;
            v4u rv[8];
#pragma unroll
            for (int it = 0; it < 8; ++it) rv[it] = *(const v4u*)(p0 + (size_t)(it * 4) * NINP);
            asm volatile("" ::: "memory");
#pragma unroll
            for (int it = 0; it < 8; ++it) { const v4u r = rv[it]; float f[8] = {bflo(r.x), bfhi(r.x), bflo(r.y), bfhi(r.y), bflo(r.z), bfhi(r.z), bflo(r.w), bfhi(r.w)};
                float ss = 0.f;
#pragma unroll
                for (int i = 0; i < 8; ++i) ss += f[i] * f[i];
                ss += __shfl_xor(ss, 1); ss += __shfl_xor(ss, 2); ss += __shfl_xor(ss, 4); ss += __shfl_xor(ss, 8);
                const float rs = rsqrtf(ss * (1.0f / 128.0f) + EPS);
                f[0] *= rs * gk0[0]; f[1] *= rs * gk0[1]; f[2] *= rs * gk0[2]; f[3] *= rs * gk0[3]; f[4] *= rs * gk1[0]; f[5] *= rs * gk1[1]; f[6] *= rs * gk1[2]; f[7] *= rs * gk1[3];
#pragma unroll
                for (int i = 0; i < 8; ++i) ms[i] += f[i];
                v4u o; o.x = pk2(f[0], f[1]); o.y = pk2(f[2], f[3]); o.z = pk2(f[4], f[5]); o.w = pk2(f[6], f[7]);
                *(v4u*)(p0 + (size_t)(it * 4) * NINP) = o; }
#pragma unroll
            for (int i = 0; i < 8; ++i) { ms[i] += __shfl_xor(ms[i], 16); ms[i] += __shfl_xor(ms[i], 32); }
            LAS float* part = (LAS float*)lds;
            if (sub == 0) { *(LAS f32x4*)(part + wave * 128 + e8) = (f32x4){ms[0], ms[1], ms[2], ms[3]}; *(LAS f32x4*)(part + wave * 128 + e8 + 4) = (f32x4){ms[4], ms[5], ms[6], ms[7]}; }
            __syncthreads();
            if (tid < 128) { float t = 0.f;
#pragma unroll
                for (int w = 0; w < 8; ++w) t += part[w * 128 + tid];
                KMEAN[(size_t)task * 128 + tid] = t * (1.0f / 256.0f); }
            __syncthreads();
        }
    }
    SEAM(4);
    if (IN(5)) {
        constexpr int NGLA = ANCHOR_GLA ? 16 : 0;
        if (ANCHOR_GLA && (int)blockIdx.x < NGLA) {
            const int bh = blockIdx.x >> 1, b = bh >> 2, h = bh & 3, v = (blockIdx.x & 1) * 128 + (tid >> 2), kp = tid & 3;
            float S[32];
#pragma unroll
            for (int i = 0; i < 32; ++i) S[i] = 0.f;
            for (int t = 0; t < T_; ++t) {
                const size_t row = (size_t)b * T_ + t; const bf16* ur = U + row * NINP;
                const v4u* qp = (const v4u*)(ur + GQ_OFF + h * 128 + kp * 32); const v4u* kpp = (const v4u*)(ur + GK_OFF + h * 128 + kp * 32);
                const f32x4* lap = (const f32x4*)(LA + row * 512 + h * 128 + kp * 32);
                const float vv = bflo((unsigned)ur[GV_OFF + h * 256 + v]);
                float o = 0.f;
#pragma unroll
                for (int i4 = 0; i4 < 4; ++i4) { const v4u qq = qp[i4], kk = kpp[i4]; const f32x4 la0 = lap[2 * i4], la1 = lap[2 * i4 + 1];
                    const float qf[8] = {bflo(qq.x), bfhi(qq.x), bflo(qq.y), bfhi(qq.y), bflo(qq.z), bfhi(qq.z), bflo(qq.w), bfhi(qq.w)};
                    const float kf[8] = {bflo(kk.x), bfhi(kk.x), bflo(kk.y), bfhi(kk.y), bflo(kk.z), bfhi(kk.z), bflo(kk.w), bfhi(kk.w)};
                    const float lf[8] = {la0[0], la0[1], la0[2], la0[3], la1[0], la1[1], la1[2], la1[3]};
#pragma unroll
                    for (int e = 0; e < 8; ++e) { const int i = i4 * 8 + e; S[i] = __expf(lf[e]) * S[i] + kf[e] * vv; o += qf[e] * S[i]; } }
                o *= 0.08838834764831845f;
                o += __shfl_xor(o, 1); o += __shfl_xor(o, 2);
                if (kp == 0) ORAW[row * 1024 + h * 256 + v] = o;
            }
        } else if (!ANCHOR_MOBA) {
            const int p = (int)blockIdx.x - NGLA, pp = p & 127;
            const int bh = pp >> 3, xx = pp & 7, b = bh >> 3, h = bh & 7;
            if (!ANCHOR_GLA && p >= 128 && p < 256) { gla_scan((p - 128) * NTHR + tid, UPDT, DEC, SPT);
                convert_range(IL_W2GU, IL_W2D, (p - 128) * NWAVES + wave, 128 * NWAVES, a, ws, (LAS float*)(lds + wave * 16384), lane); __syncthreads(); }
            if (p < 256) { const bf16* kb = U + (size_t)(b * T_) * NINP + h * 128;
                const int qb = p < 128 ? 15 - xx : xx; const size_t row0 = (size_t)b * T_ + qb * 256;
                att::attn_body<NINP, NINP, D_, 1, 2, (MV_OFF - MK_OFF) * 2, false, true>(U + row0 * NINP + MQ_OFF + h * 128, kb + MK_OFF, MIX + row0 * D_ + 1024 + h * 128, 256 * (qb + 1), (char*)lds_raw,
                                                  nullptr, nullptr, KMEAN + (size_t)(bh * 16) * 128, qb); }
        } else {
            const int nw = (G - NGLA) * NWAVES, w0 = ((int)blockIdx.x - NGLA) * NWAVES + wave;
            LAS float* sc = (LAS float*)(lds + wave * 1024);
            for (int task = w0; task < M_ * 8; task += nw) {
                const int row = task >> 3, h = task & 7, b = row >> 12, t = row & 4095, qblk = t >> 8;
                const unsigned qq = *(const unsigned*)(U + (size_t)row * NINP + MQ_OFF + h * 128 + 2 * lane);
                const float q0 = bflo(qq) * 0.08838834764831845f, q1 = bfhi(qq) * 0.08838834764831845f;
                const float* km = KMEAN + ((size_t)(b * 8 + h) * 16) * 128 + 2 * lane;
                float gt[16];
#pragma unroll
                for (int n = 0; n < 16; ++n) { const f32x2 kv = *(const f32x2*)(km + n * 128); const float d = wave_sum(q0 * kv[0] + q1 * kv[1]); gt[n] = (n < qblk) ? d : -3e38f; }
                unsigned sel = 0;
#pragma unroll
                for (int r = 0; r < 3; ++r) { float best = -3e38f; int bi = -1;
#pragma unroll
                    for (int n = 0; n < 16; ++n) if (gt[n] > best) { best = gt[n]; bi = n; }
                    if (bi >= 0) { sel |= 1u << bi;
#pragma unroll
                        for (int n = 0; n < 16; ++n) if (n == bi) gt[n] = -3e38f; } }
                sel = __builtin_amdgcn_readfirstlane(sel);
                float m = -1e30f, l = 0.f, o0 = 0.f, o1 = 0.f;
                for (int n = 0; n < qblk; ++n) if ((sel >> n) & 1u) { const bf16* kb = U + (size_t)(b * T_ + n * 256) * NINP + h * 128;
                    attn_block<false>(kb + MK_OFF, kb + MV_OFF, NINP, 256, q0, q1, m, l, o0, o1, sc, lane); }
                { const bf16* kb = U + (size_t)(b * T_ + qblk * 256) * NINP + h * 128;
                    attn_block<false>(kb + MK_OFF, kb + MV_OFF, NINP, (t & 255) + 1, q0, q1, m, l, o0, o1, sc, lane); }
                const float il = 1.0f / l;
                *(unsigned*)(MIX + (size_t)row * D_ + 1024 + h * 128 + 2 * lane) = pk2(o0 * il, o1 * il);
            }
        }
    }
    SEAM(5);
    if (IN(6) && !ANCHOR_GLA) { for (int task = blockIdx.x; task < 512; task += G) gla_c(task, U, LA, SPT, a.in[10], MIX, lds, tid); }
    if (IN(6) && ANCHOR_GLA) {
        const float* go = a.in[10]; const f32x4 gv = *(const f32x4*)(go + 4 * lane);
        for (int task = gw; task < M_ * 4; task += NGW) {
            const int row = task >> 2, h = task & 3;
            const f32x4 o = *(const f32x4*)(ORAW + (size_t)row * 1024 + h * 256 + 4 * lane);
            const float ss = wave_sum((o[0] * o[0] + o[1] * o[1]) + (o[2] * o[2] + o[3] * o[3]));
            const float rs = rsqrtf(ss * (1.0f / 256.0f) + EPS);
            const v2u rr = *(const v2u*)(U + (size_t)row * NINP + GR_OFF + h * 256 + 4 * lane);
            const float r0 = bflo(rr.x), r1 = bfhi(rr.x), r2 = bflo(rr.y), r3 = bfhi(rr.y);
            v2u pk; pk.x = pk2(o[0] * rs * gv[0] * pg8::silu_f(r0), o[1] * rs * gv[1] * pg8::silu_f(r1)); pk.y = pk2(o[2] * rs * gv[2] * pg8::silu_f(r2), o[3] * rs * gv[3] * pg8::silu_f(r3));
            *(v2u*)(MIX + (size_t)row * D_ + h * 256 + 4 * lane) = pk;
        }
    }
    SEAM(6);
    if (IN(7)) {
        pg8::Gemm g{MIX, WOUT, M_, D_, D_}; pg8::StaticOrder S; S.init(M_, D_, G, (int)blockIdx.x);
        pg8::EpiResid E{out, out, D_, 1.0f, XN, a.in[14], SS};
        pg8::gemm_phase<pg8::EpiResid, pg8::StaticOrder, true, true>(lds, g, S, E);
    }
    SEAM(7);
    if (IN(8)) {
        { pg8::Gemm g{XN, WQ, M_, 512, D_}; pg8::StaticOrder S; S.init(M_, 512, G, (int)blockIdx.x);
          pg8::EpiScale<false> E{XQ, 512, SS, nullptr};
          pg8::gemm_phase<pg8::EpiScale<false>, pg8::StaticOrder, true, true>(lds, g, S, E); }
        { pg8::Gemm g{MEMN, WKV, MM_, 1024, D_}; pg8::StaticOrder S; S.init(MM_, 1024, G, (G - 1) - (int)blockIdx.x);
          pg8::EpiScale<false> E{MKV, 1024, nullptr, nullptr};
          pg8::gemm_phase<pg8::EpiScale<false>, pg8::StaticOrder, true, true>(lds, g, S, E); }
        if ((int)blockIdx.x >= 64 && (int)blockIdx.x < 248) convert_range(IL_W2D, IL_END, ((int)blockIdx.x - 64) * NWAVES + wave, 184 * NWAVES, a, ws, (LAS float*)(lds + wave * 16384), lane);
    }
    SEAM(8);
    if (IN(9) && !ANCHOR_XATTN) {
        for (int task = blockIdx.x; task < 128; task += G) { const int b = task >> 6, h = (task >> 4) & 3, qt = task & 15; const size_t row0 = (size_t)b * T_ + qt * 256;
            const bf16* kb = MKV + (size_t)(b * MEML) * 1024 + h * 128;
            att::attn_body<512, 1024, 512, 0, 2, 1024, true, false>(XQ + row0 * 512 + h * 128, kb, XO + row0 * 512 + h * 128, MEML, (char*)lds_raw, a.in[19], a.in[20], nullptr, 0); }
    }
    if (IN(9) && ANCHOR_XATTN) {
        const float* gq = a.in[19]; const float* gk = a.in[20];
        const float gg0 = gq[2 * lane] * gk[2 * lane] * 0.08838834764831845f, gg1 = gq[2 * lane + 1] * gk[2 * lane + 1] * 0.08838834764831845f;
        LAS float* sc = (LAS float*)(lds + wave * 1024);
        for (int task = gw; task < M_ * 4; task += NGW) {
            const int row = task >> 2, h = task & 3, b = row >> 12;
            const unsigned qq = *(const unsigned*)(XQ + (size_t)row * 512 + h * 128 + 2 * lane);
            float q0 = bflo(qq), q1 = bfhi(qq);
            const float rs = rsqrtf(wave_sum(q0 * q0 + q1 * q1) * (1.0f / 128.0f) + EPS);
            q0 *= rs * gg0; q1 *= rs * gg1;
            float m = -1e30f, l = 0.f, o0 = 0.f, o1 = 0.f;
            const bf16* kb = MKV + (size_t)(b * MEML) * 1024 + h * 128;
            attn_block<true>(kb, kb + 512, 1024, MEML, q0, q1, m, l, o0, o1, sc, lane);
            const float il = 1.0f / l;
            *(unsigned*)(XO + (size_t)row * 512 + h * 128 + 2 * lane) = pk2(o0 * il, o1 * il);
        }
    }
    SEAM(9);
    if (IN(10)) {
        pg8::Gemm g{XO, WO, M_, D_, 512}; pg8::StaticOrder S; S.init(M_, D_, G, (int)blockIdx.x);
        pg8::EpiResid E{out, out, D_, 1.0f, XN, a.in[21], SS};
        pg8::gemm_phase<pg8::EpiResid, pg8::StaticOrder, true, true>(lds, g, S, E);
    }
    SEAM(10);
    if (IN(11)) {
        pg8::Gemm g{XN, W2GU, M_, NGU, D_}; pg8::StaticOrder S; S.init(M_, NGU, G, (int)blockIdx.x);
        pg8::EpiSwiGLU E{ACT, FF_, SS};
        pg8::gemm_phase<pg8::EpiSwiGLU, pg8::StaticOrder, true, true>(lds, g, S, E);
    }
    SEAM(11);
    if (IN(12)) {
        pg8::Gemm g{ACT, W2D, M_, D_, FF_}; pg8::StaticOrder S; S.init(M_, D_, G, (int)blockIdx.x);
        pg8::EpiResid E{out, out, D_, 0.5f, nullptr, nullptr, nullptr};
        pg8::gemm_phase<pg8::EpiResid, pg8::StaticOrder, true, true>(lds, g, S, E);
    }
#undef IN
#undef SEAM
#endif
}

extern "C" void kernel_launch(void* const* d_in, const int* in_sizes, int n_in, void* d_out, int out_size, void* d_ws, size_t ws_size, hipStream_t stream) {
    static int grid = 0;
    if (grid == 0) {
        if (n_in != 25 || in_sizes[0] != M_ * D_ || out_size != M_ * D_ || ws_size < WS_END) { fprintf(stderr, "kernel_launch: unexpected shapes (n_in %d, in0 %d, out %d, ws %zu < %zu); nothing launched\n", n_in, n_in > 0 ? in_sizes[0] : -1, out_size, ws_size, (size_t)WS_END); grid = -1; return; }
        int dev = 0, cus = 0, per_cu = 0;
        if (hipGetDevice(&dev) != hipSuccess || hipDeviceGetAttribute(&cus, hipDeviceAttributeMultiprocessorCount, dev) != hipSuccess) { fprintf(stderr, "kernel_launch: device query failed\n"); grid = -1; return; }
        if (hipFuncSetAttribute((const void*)hymba_fwd, hipFuncAttributeMaxDynamicSharedMemorySize, LDS_BYTES) != hipSuccess) { fprintf(stderr, "kernel_launch: hipFuncSetAttribute failed\n"); grid = -1; return; }
        if (hipOccupancyMaxActiveBlocksPerMultiprocessor(&per_cu, (const void*)hymba_fwd, NTHR, LDS_BYTES) != hipSuccess || per_cu < 1) { fprintf(stderr, "kernel_launch: occupancy query says %d blocks per CU\n", per_cu); per_cu = 1; }
        (void)hipGetLastError();
        grid = cus * 1;
        fprintf(stderr, "kernel_launch: grid %d (cus %d, per_cu %d)\n", grid, cus, per_cu);
    }
    if (grid < 0) return;
    Args a{};
    for (int i = 0; i < 25; ++i) a.in[i] = (const float*)d_in[i];
    a.out = (float*)d_out; a.ws = (unsigned char*)d_ws;
#ifdef PROBE_REP
    a.lo1 = 0; a.hi1 = PROBE_REP + 1; a.lo2 = PROBE_REP; a.hi2 = NPH;
#else
    a.lo1 = 0; a.hi1 = NPH; a.lo2 = 0; a.hi2 = 0;
#endif
    if (hipMemsetAsync(d_ws, 0, 16384, stream) != hipSuccess) { fprintf(stderr, "kernel_launch: hipMemsetAsync failed\n"); return; }
    void* args[] = {&a};
    const hipError_t e = hipLaunchCooperativeKernel((const void*)hymba_fwd, dim3(grid), dim3(NTHR), args, LDS_BYTES, stream);
    if (e != hipSuccess) fprintf(stderr, "kernel_launch: cooperative launch failed: %s (grid %d)\n", hipGetErrorString(e), grid);
}
```

```cpp
#include <hip/hip_runtime.h>
#include <hip/hip_cooperative_groups.h>
#include <cstdio>
#include <cstdint>
namespace cg = cooperative_groups;
namespace pg8 {
#define PG8_LAS __attribute__((address_space(3)))
typedef unsigned short bf16_t;
typedef short bf16x8 __attribute__((ext_vector_type(8)));
typedef float f32x4 __attribute__((ext_vector_type(4)));
typedef unsigned u32x4 __attribute__((ext_vector_type(4)));
constexpr int BM = 256, BK = 64, HALF = 128, HTB = HALF * BK * 2  , STAGE_BYTES = 8 * HTB, NXCD = 8, WGM = 8;

__host__ __device__ __forceinline__ int lds_byte(int r, int c) { const int st = (r >> 4) * 2 + (c >> 5), rr = r & 15, cc = c & 31, ob = rr * 64 + cc * 2; return st * 1024 + (ob ^ (((ob >> 9) & 1) << 5)); }
__host__ __device__ __forceinline__ void stage_rc(int b, int& R, int& C) { const int st = b / 1024, sb = b % 1024, swz = sb ^ (((sb >> 9) & 1) << 5); R = (st >> 1) * 16 + swz / 64; C = (st & 1) * 32 + (swz % 64) / 2; }
__host__ __device__ __forceinline__ int perm32(int rho) { const int n = rho >> 4, i = rho & 15; return 8 * (i >> 2) + 4 * n + (i & 3); }

struct Unit { int pm, pn; };
struct Gemm { const bf16_t* A; const bf16_t* Bt; int M, N, K; };

struct StaticOrder {
    int nM, nN, nwg, G, c;
    __host__ __device__ void init(int M, int N, int G_, int c_) { nM = M / BM; nN = N / BM; nwg = nM * nN; G = G_; c = c_; }
    __host__ __device__ bool next(int i, Unit& u) const {
        const long L = (long)i * G + c; if (L >= nwg) return false;
        int wgid = (int)L; { const int q = nwg / NXCD, r = nwg % NXCD, xcd = wgid % NXCD, off = wgid / NXCD; wgid = (xcd < r ? xcd * (q + 1) : r * (q + 1) + (xcd - r) * q) + off; }
        const int nig = WGM * nN, gid = wgid / nig, fm = gid * WGM, gsz = (nM - fm) < WGM ? (nM - fm) : WGM;
        u.pm = fm + ((wgid % nig) % gsz); u.pn = (wgid % nig) / gsz; return true;
    }
    __device__ __forceinline__ void a_ready(const Unit&) const {}
    __device__ __forceinline__ void done(const Unit&) const {}
};


__device__ __forceinline__ unsigned cvt_pk_bf16(float lo, float hi) { unsigned r; asm volatile("v_cvt_pk_bf16_f32 %0, %1, %2" : "=v"(r) : "v"(lo), "v"(hi)); return r; }
typedef unsigned u32x2 __attribute__((ext_vector_type(2)));

__device__ __forceinline__ float row_rs(const float* SS, int row, int fq) {
    const f32x4* p = (const f32x4*)(SS + (size_t)row * 32 + fq * 8);
    const f32x4 a = p[0], b = p[1];
    float s = ((a[0] + a[1]) + (a[2] + a[3])) + ((b[0] + b[1]) + (b[2] + b[3]));
    s += __shfl_xor(s, 16); s += __shfl_xor(s, 32);
    return rsqrtf(s * (1.0f / 2048.0f) + 1e-6f);
}
__device__ __forceinline__ float silu_f(float g) { return g * __builtin_amdgcn_rcpf(1.0f + __expf(-g)); }

struct EpiSwiGLU {
    static constexpr bool PERM = true, AFTER_DRAIN = false;
    bf16_t* O; int ldc; const float* SS;
    __device__ __forceinline__ void operator()(const f32x4 (&acc)[2][2][4][2], const Unit& u, int wr, int wc, int fr, int fq) const {
        const int row0 = u.pm * BM + wr * 64 + fr, col0 = u.pn * HALF + wc * 32 + 8 * fq;
#pragma unroll
        for (int ai = 0; ai < 2; ++ai)
#pragma unroll
            for (int m = 0; m < 4; ++m) {
                const int row = row0 + ai * HALF + m * 16;
                const float rs = row_rs(SS, row, fq);
                float v[8];
#pragma unroll
                for (int n = 0; n < 2; ++n)
#pragma unroll
                    for (int j = 0; j < 4; ++j) { const float g = acc[ai][0][m][n][j] * rs, up = acc[ai][1][m][n][j] * rs; v[n * 4 + j] = silu_f(g) * up; }
                u32x4 w; w.x = cvt_pk_bf16(v[0], v[1]); w.y = cvt_pk_bf16(v[2], v[3]); w.z = cvt_pk_bf16(v[4], v[5]); w.w = cvt_pk_bf16(v[6], v[7]);
                *(u32x4*)(O + (size_t)row * ldc + col0) = w;
            }
    }
};

struct EpiResid {
    static constexpr bool PERM = false, AFTER_DRAIN = false;
    const float* base; float* out; int ldc; float alpha; bf16_t* XN; const float* gain; float* SS;
    __device__ __forceinline__ void operator()(const f32x4 (&acc)[2][2][4][2], const Unit& u, int wr, int wc, int fr, int fq) const {
        const int row0 = u.pm * BM + wr * 64 + fr, col0 = u.pn * BM + wc * 32 + 4 * fq;
#pragma unroll
        for (int ai = 0; ai < 2; ++ai)
#pragma unroll
            for (int m = 0; m < 4; ++m) {
                const int row = row0 + ai * HALF + m * 16; const size_t off = (size_t)row * ldc + col0; float ssq = 0.f;
#pragma unroll
                for (int bj = 0; bj < 2; ++bj)
#pragma unroll
                    for (int n = 0; n < 2; ++n) { const int c = bj * HALF + n * 16;
                        const f32x4 b = *(const f32x4*)(base + off + c); const f32x4 o = b + acc[ai][bj][m][n] * alpha;
                        *(f32x4*)(out + off + c) = o;
                        if (XN) { const f32x4 gv = *(const f32x4*)(gain + col0 + c); const f32x4 w = o * gv;
                            u32x2 pk; pk.x = cvt_pk_bf16(w[0], w[1]); pk.y = cvt_pk_bf16(w[2], w[3]); *(u32x2*)(XN + off + c) = pk;
                            ssq += (o[0] * o[0] + o[1] * o[1]) + (o[2] * o[2] + o[3] * o[3]); } }
                if (SS) { ssq += __shfl_xor(ssq, 16); ssq += __shfl_xor(ssq, 32); if (fq == 0) SS[(size_t)row * 32 + u.pn * 4 + wc] = ssq; }
                asm volatile("" ::: "memory");
            }
    }
};

template <bool BASEBF, bool OUTF32> struct EpiRes2 {
    static constexpr bool PERM = false, AFTER_DRAIN = false;
    const void* base; void* out; int ldc; float alpha; float* SS;
    __device__ __forceinline__ void operator()(const f32x4 (&acc)[2][2][4][2], const Unit& u, int wr, int wc, int fr, int fq) const {
        const int row0 = u.pm * BM + wr * 64 + fr, col0 = u.pn * BM + wc * 32 + 4 * fq;
#pragma unroll
        for (int ai = 0; ai < 2; ++ai)
#pragma unroll
            for (int m = 0; m < 4; ++m) {
                const int row = row0 + ai * HALF + m * 16; const size_t off = (size_t)row * ldc + col0; float ssq = 0.f;
#pragma unroll
                for (int bj = 0; bj < 2; ++bj)
#pragma unroll
                    for (int n = 0; n < 2; ++n) { const int c = bj * HALF + n * 16; f32x4 b;
                        if (BASEBF) { const u32x2 r = *(const u32x2*)((const bf16_t*)base + off + c);
                            b = (f32x4){__builtin_bit_cast(float, r.x << 16), __builtin_bit_cast(float, r.x & 0xffff0000u), __builtin_bit_cast(float, r.y << 16), __builtin_bit_cast(float, r.y & 0xffff0000u)}; }
                        else b = *(const f32x4*)((const float*)base + off + c);
                        const f32x4 o = b + acc[ai][bj][m][n] * alpha;
                        if (OUTF32) *(f32x4*)((float*)out + off + c) = o;
                        else { u32x2 pk; pk.x = cvt_pk_bf16(o[0], o[1]); pk.y = cvt_pk_bf16(o[2], o[3]); *(u32x2*)((bf16_t*)out + off + c) = pk; }
                        ssq += (o[0] * o[0] + o[1] * o[1]) + (o[2] * o[2] + o[3] * o[3]); }
                if (SS) { ssq += __shfl_xor(ssq, 16); ssq += __shfl_xor(ssq, 32); if (fq == 0) SS[(size_t)row * 32 + u.pn * 4 + wc] = ssq; }
                asm volatile("" ::: "memory");
            }
    }
};

template <bool LRX> struct EpiScale {
    static constexpr bool PERM = true, AFTER_DRAIN = false;
    bf16_t* O; int ldc; const float* SS; float* LR;
    __device__ __forceinline__ void operator()(const f32x4 (&acc)[2][2][4][2], const Unit& u, int wr, int wc, int fr, int fq) const {
        const int row0 = u.pm * BM + wr * 64 + fr, col0 = u.pn * BM + wc * 32 + 8 * fq;
#pragma unroll
        for (int ai = 0; ai < 2; ++ai)
#pragma unroll
            for (int m = 0; m < 4; ++m) {
                const int row = row0 + ai * HALF + m * 16;
                const float rs = SS ? row_rs(SS, row, fq) : 1.0f;
#pragma unroll
                for (int bj = 0; bj < 2; ++bj) { const f32x4 v0 = acc[ai][bj][m][0] * rs, v1 = acc[ai][bj][m][1] * rs;
                    u32x4 w; w.x = cvt_pk_bf16(v0[0], v0[1]); w.y = cvt_pk_bf16(v0[2], v0[3]); w.z = cvt_pk_bf16(v1[0], v1[1]); w.w = cvt_pk_bf16(v1[2], v1[3]);
                    *(u32x4*)(O + (size_t)row * ldc + col0 + bj * HALF) = w;
                    if (LRX) { if (u.pn == 12 && bj == 0 && wc == 0 && fq < 2) { *(f32x4*)(LR + (size_t)row * 16 + 8 * fq) = v0; *(f32x4*)(LR + (size_t)row * 16 + 8 * fq + 4) = v1; } } }
            }
    }
};
template <class Epi, class Sched, bool ALIGN_EPI = false, bool SP2 = false>
__device__ __forceinline__ void gemm_phase(PG8_LAS unsigned char* lds, const Gemm g, const Sched& S, const Epi& E) {
    const int tid = threadIdx.x, wid = __builtin_amdgcn_readfirstlane(tid >> 6), lane = tid & 63, wr = wid >> 2, wc = wid & 3, fr = lane & 15, fq = lane >> 4;
    const int K = g.K, nt = K / BK;
    unsigned voffA[2], voffB[2];
#pragma unroll
    for (int i = 0; i < 2; ++i) { int R, C; stage_rc(tid * 16 + i * 8192, R, C); const int Rb = Epi::PERM ? ((R & ~31) + perm32(R & 31)) : R;
        voffA[i] = (unsigned)(R * K + C) * 2u; voffB[i] = (unsigned)(Rb * K + C) * 2u; }
    const size_t kstep = (size_t)(BK * 2);
    const size_t hstep = (size_t)HALF * K * 2;
    const size_t tstep = 2 * hstep;
    const unsigned ldsw = (unsigned)wid * 1024u;
    const int aoff = lds_byte(wr * 64 + fr, fq * 8), boff = lds_byte(wc * 32 + fr, fq * 8);
#define PG8_SA(b, h) (((b) * 2 + (h)) * HTB)
#define PG8_SB(b, h) ((4 + (b) * 2 + (h)) * HTB)
#define PG8_STAGE(bufoff, gbase, voff) do { _Pragma("unroll") for (int _i = 0; _i < 2; ++_i) \
        __builtin_amdgcn_global_load_lds((const unsigned*)((const char*)(gbase) + (voff)[_i]), (PG8_LAS unsigned*)(lds + (bufoff) + ldsw + _i * 8192), 16, 0, 0); } while (0)
#define PG8_LDA(dst, b, h) do { _Pragma("unroll") for (int m = 0; m < 4; ++m) _Pragma("unroll") for (int k = 0; k < 2; ++k) dst[m][k] = *(const PG8_LAS bf16x8*)(lds + PG8_SA(b, h) + aoff + m * 2048 + k * 1024); } while (0)
#define PG8_LDB(dst, b, h) do { _Pragma("unroll") for (int n = 0; n < 2; ++n) _Pragma("unroll") for (int k = 0; k < 2; ++k) dst[n][k] = *(const PG8_LAS bf16x8*)(lds + PG8_SB(b, h) + boff + n * 2048 + k * 1024); } while (0)
#define PG8_MMA(ai, bj, At, Bt) do { __builtin_amdgcn_s_setprio(1); _Pragma("unroll") for (int m = 0; m < 4; ++m) _Pragma("unroll") for (int n = 0; n < 2; ++n) _Pragma("unroll") for (int k = 0; k < 2; ++k) \
        acc[ai][bj][m][n] = __builtin_amdgcn_mfma_f32_16x16x32_bf16(Bt[n][k], At[m][k], acc[ai][bj][m][n], 0, 0, 0); __builtin_amdgcn_s_setprio(0); } while (0)
#define PG8_WAIT_V(n) asm volatile("s_waitcnt vmcnt(" #n ")" ::: "memory")
#define PG8_WAIT_L(n) asm volatile("s_waitcnt lgkmcnt(" #n ")" ::: "memory")
#define PG8_BAR __builtin_amdgcn_s_barrier()
#define PG8_SCHED __builtin_amdgcn_sched_barrier(0)
    Unit cur, nxt; int ui = 0;
    if (!S.next(0, cur)) return;
    f32x4 acc[2][2][4][2];
#pragma unroll
    for (int a = 0; a < 2; ++a)
#pragma unroll
        for (int b = 0; b < 2; ++b)
#pragma unroll
            for (int m = 0; m < 4; ++m)
#pragma unroll
                for (int n = 0; n < 2; ++n) acc[a][b][m][n] = (f32x4){0.f, 0.f, 0.f, 0.f};
    bf16x8 At[4][2], B0[2][2], B1[2][2];
    const char* cA = (const char*)g.A + (size_t)cur.pm * tstep; const char* cB = (const char*)g.Bt + (size_t)cur.pn * tstep;
    S.a_ready(cur);
    if constexpr (SP2) {
        PG8_STAGE(PG8_SB(0, 0), cB, voffB); PG8_STAGE(PG8_SB(0, 1), cB + hstep, voffB); PG8_STAGE(PG8_SA(0, 0), cA, voffA); PG8_STAGE(PG8_SA(0, 1), cA + hstep, voffA);
        if (wr == 1) PG8_BAR;
        PG8_WAIT_V(2); PG8_BAR;
        PG8_STAGE(PG8_SB(1, 0), cB + kstep, voffB); PG8_STAGE(PG8_SA(1, 0), cA + kstep, voffA); PG8_STAGE(PG8_SB(1, 1), cB + hstep + kstep, voffB);
        PG8_WAIT_V(6); PG8_BAR;
    } else {
        PG8_STAGE(PG8_SB(0, 0), cB, voffB); PG8_STAGE(PG8_SA(0, 0), cA, voffA); PG8_STAGE(PG8_SB(0, 1), cB + hstep, voffB); PG8_STAGE(PG8_SA(0, 1), cA + hstep, voffA);
        if (wr == 1) PG8_BAR;
        PG8_WAIT_V(4); PG8_BAR;
        PG8_STAGE(PG8_SB(1, 0), cB + kstep, voffB); PG8_STAGE(PG8_SA(1, 0), cA + kstep, voffA); PG8_STAGE(PG8_SB(1, 1), cB + hstep + kstep, voffB);
        PG8_WAIT_V(6); PG8_BAR;
    }
    for (;;) {
        const bool has_next = S.next(ui + 1, nxt);
        const char* nA = has_next ? (const char*)g.A + (size_t)nxt.pm * tstep : cA; const char* nB = has_next ? (const char*)g.Bt + (size_t)nxt.pn * tstep : cB;
        for (int t = 0; t < nt; t += 2) {
            const bool last = (t == nt - 2);
            const char* a1 = cA + (size_t)(t + 1) * kstep;
            const char* a2 = last ? nA : cA + (size_t)(t + 2) * kstep; const char* b2 = last ? nB : cB + (size_t)(t + 2) * kstep;
            const char* a3 = a2 + kstep; const char* b3 = b2 + kstep;
            if (last && has_next) S.a_ready(nxt);
            if constexpr (SP2) {
            PG8_LDB(B0, 0, 0); PG8_LDB(B1, 0, 1); PG8_SCHED; PG8_LDA(At, 0, 0); PG8_STAGE(PG8_SA(1, 1), a1 + hstep, voffA);
            PG8_WAIT_V(8); PG8_WAIT_L(0); PG8_BAR; PG8_MMA(0, 0, At, B0); PG8_MMA(0, 1, At, B1); PG8_BAR; PG8_SCHED;
            PG8_LDA(At, 0, 1); PG8_STAGE(PG8_SB(0, 0), b2, voffB); PG8_STAGE(PG8_SB(0, 1), b2 + hstep, voffB); PG8_STAGE(PG8_SA(0, 0), a2, voffA);
            PG8_WAIT_V(8); PG8_WAIT_L(0); PG8_BAR; PG8_MMA(1, 0, At, B0); PG8_MMA(1, 1, At, B1); PG8_BAR; PG8_SCHED;
            PG8_LDB(B0, 1, 0); PG8_LDB(B1, 1, 1); PG8_SCHED; PG8_LDA(At, 1, 0); PG8_STAGE(PG8_SA(0, 1), a2 + hstep, voffA);
            PG8_WAIT_V(8); PG8_WAIT_L(0); PG8_BAR; PG8_MMA(0, 0, At, B0); PG8_MMA(0, 1, At, B1); PG8_BAR; PG8_SCHED;
            PG8_LDA(At, 1, 1); PG8_STAGE(PG8_SB(1, 0), b3, voffB); PG8_STAGE(PG8_SB(1, 1), b3 + hstep, voffB); PG8_STAGE(PG8_SA(1, 0), a3, voffA);
            PG8_WAIT_V(8); PG8_WAIT_L(0); PG8_BAR; PG8_MMA(1, 0, At, B0); PG8_MMA(1, 1, At, B1); PG8_BAR; PG8_SCHED;
            } else {
            PG8_LDB(B0, 0, 0); PG8_SCHED; PG8_LDA(At, 0, 0); PG8_STAGE(PG8_SA(1, 1), a1 + hstep, voffA);
            PG8_WAIT_L(8); PG8_BAR; PG8_WAIT_L(0); PG8_MMA(0, 0, At, B0); PG8_BAR; PG8_SCHED;
            PG8_LDB(B1, 0, 1); PG8_STAGE(PG8_SB(0, 0), b2, voffB);
            PG8_BAR; PG8_WAIT_L(0); PG8_MMA(0, 1, At, B1); PG8_BAR;
            PG8_LDA(At, 0, 1); PG8_STAGE(PG8_SA(0, 0), a2, voffA);
            PG8_BAR; PG8_WAIT_L(0); PG8_MMA(1, 0, At, B0); PG8_BAR; PG8_SCHED;
            PG8_STAGE(PG8_SB(0, 1), b2 + hstep, voffB);
            PG8_WAIT_V(6); PG8_BAR; PG8_MMA(1, 1, At, B1); PG8_BAR;
            PG8_LDB(B0, 1, 0); PG8_SCHED; PG8_LDA(At, 1, 0); PG8_STAGE(PG8_SA(0, 1), a2 + hstep, voffA);
            PG8_WAIT_L(8); PG8_BAR; PG8_WAIT_L(0); PG8_MMA(0, 0, At, B0); PG8_BAR; PG8_SCHED;
            PG8_LDB(B1, 1, 1); PG8_STAGE(PG8_SB(1, 0), b3, voffB);
            PG8_BAR; PG8_WAIT_L(0); PG8_MMA(0, 1, At, B1); PG8_BAR;
            PG8_LDA(At, 1, 1); PG8_STAGE(PG8_SA(1, 0), a3, voffA);
            PG8_BAR; PG8_WAIT_L(0); PG8_MMA(1, 0, At, B0); PG8_BAR; PG8_SCHED;
            PG8_STAGE(PG8_SB(1, 1), b3 + hstep, voffB);
            PG8_WAIT_V(6); PG8_BAR; PG8_MMA(1, 1, At, B1); PG8_BAR;
            }
        }
        if constexpr (ALIGN_EPI) { if (wr == 0) PG8_BAR; }
        if constexpr (!Epi::AFTER_DRAIN) { E(acc, cur, wr, wc, fr, fq); S.done(cur); }
        if (!has_next) break;
#pragma unroll
        for (int a = 0; a < 2; ++a)
#pragma unroll
            for (int b = 0; b < 2; ++b)
#pragma unroll
                for (int m = 0; m < 4; ++m)
#pragma unroll
                    for (int n = 0; n < 2; ++n) acc[a][b][m][n] = (f32x4){0.f, 0.f, 0.f, 0.f};
        cur = nxt; cA = nA; cB = nB; ++ui;
        if constexpr (ALIGN_EPI) { if (wr == 1) PG8_BAR; }
    }
    PG8_WAIT_V(0);
    if constexpr (!ALIGN_EPI) { if (wr == 0) PG8_BAR; }
    PG8_BAR;
    if constexpr (Epi::AFTER_DRAIN) { E.fused(acc, cur, wr, wc, fr, fq, lds, wid, lane); S.done(cur); }
#undef PG8_SA
#undef PG8_SB
#undef PG8_STAGE
#undef PG8_LDA
#undef PG8_LDB
#undef PG8_MMA
#undef PG8_WAIT_V
#undef PG8_WAIT_L
#undef PG8_BAR
#undef PG8_SCHED
}
}

constexpr int NWAVES = 8, NTHR = 512;
constexpr int B_ = 2, T_ = 4096, D_ = 2048, M_ = B_ * T_, FF_ = 5632, NGU = 2 * FF_, MEML = 256, MM_ = B_ * MEML;
constexpr int NIN = 6160, NINP = 6400;
constexpr int GQ_OFF = 0, GK_OFF = 512, GV_OFF = 1024, GR_OFF = 2048, MQ_OFF = 3072, MK_OFF = 4096, MV_OFF = 5120, NU = 6144;
constexpr float EPS = 1e-6f;
#ifndef MK_MULTI
#define MK_MULTI 0
#endif
#ifndef ANCHOR_GLA
#define ANCHOR_GLA 0
#endif
#ifndef ANCHOR_MOBA
#define ANCHOR_MOBA 0
#endif
#ifndef ANCHOR_XATTN
#define ANCHOR_XATTN 0
#endif
constexpr int NPH = 13;

constexpr size_t MiB = 1u << 20;
constexpr size_t WS_W1GU = 1 * MiB, WS_W1D = 45 * MiB, WS_W2GU = 67 * MiB, WS_W2D = 111 * MiB, WS_WIN = 133 * MiB, WS_WOUT = 158 * MiB,
                 WS_WQ = 166 * MiB, WS_WKV = 168 * MiB, WS_WO = 172 * MiB;
constexpr size_t WS_XN = 174 * MiB, WS_MEMN = 206 * MiB, WS_SS = 208 * MiB;
constexpr size_t WS_ACT = 209 * MiB;
constexpr size_t WS_XQ = WS_ACT, WS_XO = WS_ACT + 8 * MiB, WS_MKV = WS_ACT + 16 * MiB;
constexpr size_t WS_LR = 309 * MiB, WS_LA = 310 * MiB, WS_MIX = 326 * MiB, WS_KMEAN = 358 * MiB, WS_SPT = 359 * MiB, WS_END = 391 * MiB;
constexpr int LDS_BYTES = 147456;

#define LAS __attribute__((address_space(3)))
typedef unsigned short bf16;
typedef unsigned v4u __attribute__((ext_vector_type(4)));
typedef unsigned v2u __attribute__((ext_vector_type(2)));
typedef float f32x4 __attribute__((ext_vector_type(4)));
typedef float f32x2 __attribute__((ext_vector_type(2)));
#define LDS_WAIT() asm volatile("s_waitcnt lgkmcnt(0)" ::: "memory")
__device__ __forceinline__ unsigned f2bf(float f) { unsigned u = __builtin_bit_cast(unsigned, f); return (u + 0x7fffu + ((u >> 16) & 1u)) >> 16; }
__device__ __forceinline__ unsigned pk2(float lo, float hi) { return f2bf(lo) | (f2bf(hi) << 16); }
__device__ __forceinline__ float bflo(unsigned u) { return __builtin_bit_cast(float, u << 16); }
__device__ __forceinline__ float bfhi(unsigned u) { return __builtin_bit_cast(float, u & 0xffff0000u); }
__device__ __forceinline__ float wave_sum(float v) {
#pragma unroll
    for (int o = 1; o < 64; o <<= 1) v += __shfl_xor(v, o);
    return v;
}


#ifndef ATT_NOMASK
#define ATT_NOMASK 0
#endif
#ifndef ATT_NOGATE
#define ATT_NOGATE 0
#endif
namespace att {
typedef unsigned short bf16;
using bf16x8 = __attribute__((ext_vector_type(8))) short;
using s16x4  = __attribute__((ext_vector_type(4))) short;
using f32x16 = __attribute__((ext_vector_type(16))) float;
using f32x4  = __attribute__((ext_vector_type(4))) float;
using u32x4  = __attribute__((ext_vector_type(4))) unsigned;
constexpr int   D = 128, NW = 8, QBLK = 32, KVBLK = 64;
constexpr float SCALE = 0.088388347648318440f;
constexpr float THR = 8.f;
constexpr size_t SHM_V = KVBLK * D * 2, SHM_K = KVBLK * D * 2, SHM_ATTN = 2 * SHM_V + 2 * SHM_K + NW * 64 * 4;
#define KSWZ(row, colB) ((row) * 256 + ((colB) ^ (((row) & 7) << 4)))
#define SBAR() __builtin_amdgcn_sched_barrier(0)
__device__ __forceinline__ int crow(int r, int hi) { return (r & 3) + 8 * (r >> 2) + 4 * hi; }
__device__ __forceinline__ unsigned cvtpk(float lo, float hi) { unsigned r; asm volatile("v_cvt_pk_bf16_f32 %0, %1, %2" : "=v"(r) : "v"(lo), "v"(hi)); return r; }
__device__ __forceinline__ float blo(unsigned u) { return __builtin_bit_cast(float, u << 16); }
__device__ __forceinline__ float bhi(unsigned u) { return __builtin_bit_cast(float, u & 0xffff0000u); }

__device__ __forceinline__ void partialSM(f32x16& p0, f32x16& p1, float& m_reg, float& mn, float& alpha) {
  constexpr float C = SCALE * 1.4426950408889634f;
  float pmax = p0[0]; for (int r = 1; r < 16; ++r) pmax = fmaxf(pmax, p0[r]); for (int r = 0; r < 16; ++r) pmax = fmaxf(pmax, p1[r]);
  { auto rr = __builtin_amdgcn_permlane32_swap(__float_as_uint(pmax), __float_as_uint(pmax), false, false);
    pmax = fmaxf(__uint_as_float(rr[0]), __uint_as_float(rr[1])); }
  if (__builtin_expect(__all(pmax - m_reg <= THR / SCALE), 1)) { mn = m_reg; alpha = 1.f; }
  else { mn = fmaxf(m_reg, pmax); alpha = __builtin_amdgcn_exp2f((m_reg - mn) * C); m_reg = mn; }
  float mnC = -mn * C;
  for (int r = 0; r < 16; ++r) p0[r] = fmaf(p0[r], C, mnC); for (int r = 0; r < 16; ++r) p1[r] = fmaf(p1[r], C, mnC);
  for (int r = 0; r < 16; ++r) p0[r] = __builtin_amdgcn_exp2f(p0[r]);
}
__device__ __forceinline__ void finishSM(f32x16& p0, f32x16& p1, float alpha, float& l_reg, bf16x8& pa0, bf16x8& pa1, bf16x8& pa2, bf16x8& pa3) {
  for (int r = 0; r < 16; ++r) p1[r] = __builtin_amdgcn_exp2f(p1[r]);
  float ps = 0; for (int r = 0; r < 16; ++r) ps += p0[r]; for (int r = 0; r < 16; ++r) ps += p1[r];
  { auto rr = __builtin_amdgcn_permlane32_swap(__float_as_uint(ps), __float_as_uint(ps), false, false);
    ps = __uint_as_float(rr[0]) + __uint_as_float(rr[1]); }
  l_reg = l_reg * alpha + ps;
#define PK4(P, BASE, OUT) do { unsigned a0 = cvtpk(P[BASE + 0], P[BASE + 1]), a1 = cvtpk(P[BASE + 2], P[BASE + 3]);   \
    unsigned b0 = cvtpk(P[BASE + 4], P[BASE + 5]), b1 = cvtpk(P[BASE + 6], P[BASE + 7]);                              \
    auto r0 = __builtin_amdgcn_permlane32_swap(a0, b0, false, false); auto r1 = __builtin_amdgcn_permlane32_swap(a1, b1, false, false); \
    u32x4 w = {r0[0], r1[0], r0[1], r1[1]}; OUT = *reinterpret_cast<bf16x8*>(&w); } while (0)
  PK4(p0, 0, pa0); PK4(p0, 8, pa1); PK4(p1, 0, pa2); PK4(p1, 8, pa3);
#undef PK4
}
__device__ __forceinline__ void qkt(f32x16& p0, f32x16& p1, const bf16* Ks, const bf16x8* qr, int r32, int hi) {
  p0 = f32x16{}; p1 = f32x16{};
  for (int d0 = 0; d0 < 8; ++d0) { int cb = (d0 * 16 + hi * 8) * 2;
    bf16x8 b0 = *reinterpret_cast<const bf16x8*>((const char*)Ks + KSWZ(r32, cb));
    bf16x8 b1 = *reinterpret_cast<const bf16x8*>((const char*)Ks + KSWZ(32 + r32, cb));
    p0 = __builtin_amdgcn_mfma_f32_32x32x16_bf16(b0, qr[d0], p0, 0, 0, 0);
    p1 = __builtin_amdgcn_mfma_f32_32x32x16_bf16(b1, qr[d0], p1, 0, 0, 0); }
}
__device__ __forceinline__ void qkt_l(f32x16& p0, f32x16& p1, const bf16* Ks, const char* Qs, int qrow, int r32, int hi) {
  p0 = f32x16{}; p1 = f32x16{};
  int qopq = 0; asm volatile("" : "+v"(qopq));
  for (int d0 = 0; d0 < 8; ++d0) { int cb = (d0 * 16 + hi * 8) * 2;
    bf16x8 b0 = *reinterpret_cast<const bf16x8*>((const char*)Ks + KSWZ(r32, cb));
    bf16x8 b1 = *reinterpret_cast<const bf16x8*>((const char*)Ks + KSWZ(32 + r32, cb));
    bf16x8 q = *reinterpret_cast<const bf16x8*>(Qs + qopq + KSWZ(qrow, cb));
    p0 = __builtin_amdgcn_mfma_f32_32x32x16_bf16(b0, q, p0, 0, 0, 0);
    p1 = __builtin_amdgcn_mfma_f32_32x32x16_bf16(b1, q, p1, 0, 0, 0); }
}
__device__ __forceinline__ int v_st(int k, int c) { const int kk = (k & ~0xC) | ((k & 4) << 1) | ((k & 8) >> 1); return ((kk >> 3) * 4 + (c >> 5)) * 512 + ((kk & 7) * 32 + (c & 31)) * 2; }
__device__ __forceinline__ int v_rd_base(int lane) { return ((lane & 3) << 3) | (((lane >> 2) & 3) << 6) | (((lane >> 4) & 1) << 5) | (((lane >> 5) & 1) << 8); }
constexpr int v_rd_off(int d0, int ks, int half) { return d0 * 512 + ks * 4096 + half * 2048; }
template <int OFF> __device__ __forceinline__ s16x4 tr_read(int vb) {
  s16x4 r; asm volatile("ds_read_b64_tr_b16 %0, %1 offset:%2" : "=&v"(r) : "v"(vb), "i"(OFF) : "memory"); return r;
}
template <int D0> __device__ __forceinline__ void pv_one(f32x16& od, int vb, bf16x8 pa0, bf16x8 pa1, bf16x8 pa2, bf16x8 pa3) {
  const s16x4 l0 = tr_read<v_rd_off(D0, 0, 0)>(vb), h0 = tr_read<v_rd_off(D0, 0, 1)>(vb), l1 = tr_read<v_rd_off(D0, 1, 0)>(vb), h1 = tr_read<v_rd_off(D0, 1, 1)>(vb);
  const s16x4 l2 = tr_read<v_rd_off(D0, 2, 0)>(vb), h2 = tr_read<v_rd_off(D0, 2, 1)>(vb), l3 = tr_read<v_rd_off(D0, 3, 0)>(vb), h3 = tr_read<v_rd_off(D0, 3, 1)>(vb);
  asm volatile("s_waitcnt lgkmcnt(0)" ::: "memory"); SBAR();
#define PK(L, H) (bf16x8){L[0], L[1], L[2], L[3], H[0], H[1], H[2], H[3]}
  od = __builtin_amdgcn_mfma_f32_32x32x16_bf16(pa0, PK(l0, h0), od, 0, 0, 0);
  od = __builtin_amdgcn_mfma_f32_32x32x16_bf16(pa1, PK(l1, h1), od, 0, 0, 0);
  od = __builtin_amdgcn_mfma_f32_32x32x16_bf16(pa2, PK(l2, h2), od, 0, 0, 0);
  od = __builtin_amdgcn_mfma_f32_32x32x16_bf16(pa3, PK(l3, h3), od, 0, 0, 0);
#undef PK
}
__device__ __forceinline__ void pv_d0(f32x16* o, int vb, bf16x8 pa0, bf16x8 pa1, bf16x8 pa2, bf16x8 pa3) {
  pv_one<0>(o[0], vb, pa0, pa1, pa2, pa3); pv_one<1>(o[1], vb, pa0, pa1, pa2, pa3); pv_one<2>(o[2], vb, pa0, pa1, pa2, pa3); pv_one<3>(o[3], vb, pa0, pa1, pa2, pa3);
}
__device__ __forceinline__ bf16x8 knorm8(bf16x8 v, const float* g) {
  const u32x4 w = *reinterpret_cast<const u32x4*>(&v);
  float f[8] = {blo(w.x), bhi(w.x), blo(w.y), bhi(w.y), blo(w.z), bhi(w.z), blo(w.w), bhi(w.w)};
  float ss = 0.f;
#pragma unroll
  for (int i = 0; i < 8; ++i) ss += f[i] * f[i];
  ss += __shfl_xor(ss, 1); ss += __shfl_xor(ss, 2); ss += __shfl_xor(ss, 4); ss += __shfl_xor(ss, 8);
  const float rs = rsqrtf(ss * (1.0f / 128.0f) + 1e-6f);
  u32x4 o = {cvtpk(f[0] * rs * g[0], f[1] * rs * g[1]), cvtpk(f[2] * rs * g[2], f[3] * rs * g[3]), cvtpk(f[4] * rs * g[4], f[5] * rs * g[5]), cvtpk(f[6] * rs * g[6], f[7] * rs * g[7])};
  return *reinterpret_cast<bf16x8*>(&o);
}

template <int LDQ, int LDK, int LDO, int MODE, int SD, int VOFFB, bool PIPE, bool QL>
__device__ __forceinline__ void attn_body(const bf16* __restrict__ Qb, const bf16* __restrict__ Kh, bf16* __restrict__ Ob, int seq, char* lds,
                                          const float* __restrict__ gq, const float* __restrict__ gk, const float* __restrict__ kmean, int qblk) {
  const int tid = threadIdx.x, wid = tid >> 6, lane = tid & 63, r32 = lane & 31, hi = lane >> 5;
  bf16* V_lds = (bf16*)lds; bf16* K_lds = (bf16*)(lds + 2 * SHM_V);
  float* ws = (float*)(lds + 2 * SHM_V + 2 * SHM_K) + wid * 64; float* li_l = ws; float* al_l = ws + 32;
  float m_reg = -1e30f, l_reg = 0; f32x16 o[4] = {}; bf16x8 qr[8];
  const bf16* Qw = Qb + (long)(wid * QBLK + r32) * LDQ + hi * 8;
#pragma unroll
  for (int d0 = 0; d0 < 8; ++d0) qr[d0] = *reinterpret_cast<const bf16x8*>(Qw + d0 * 16);
  unsigned sel = 0;
  if constexpr (MODE == 0) {
    float ss = 0.f;
#pragma unroll
    for (int d0 = 0; d0 < 8; ++d0) { const u32x4 w = *reinterpret_cast<const u32x4*>(&qr[d0]);
      const float f[8] = {blo(w.x), bhi(w.x), blo(w.y), bhi(w.y), blo(w.z), bhi(w.z), blo(w.w), bhi(w.w)};
#pragma unroll
      for (int i = 0; i < 8; ++i) ss += f[i] * f[i]; }
    ss += __shfl_xor(ss, 32);
    const float rs = rsqrtf(ss * (1.0f / 128.0f) + 1e-6f);
#pragma unroll
    for (int d0 = 0; d0 < 8; ++d0) { const u32x4 w = *reinterpret_cast<const u32x4*>(&qr[d0]);
      const f32x4 g0 = *reinterpret_cast<const f32x4*>(gq + d0 * 16 + hi * 8), g1 = *reinterpret_cast<const f32x4*>(gq + d0 * 16 + hi * 8 + 4);
      u32x4 ow = {cvtpk(blo(w.x) * rs * g0[0], bhi(w.x) * rs * g0[1]), cvtpk(blo(w.y) * rs * g0[2], bhi(w.y) * rs * g0[3]), cvtpk(blo(w.z) * rs * g1[0], bhi(w.z) * rs * g1[1]), cvtpk(blo(w.w) * rs * g1[2], bhi(w.w) * rs * g1[3])};
      qr[d0] = *reinterpret_cast<bf16x8*>(&ow); }
  }
  if constexpr (MODE == 1 && !ATT_NOGATE) {
    float* km_l = (float*)(lds + SHM_ATTN + 512 + 65536);
    *reinterpret_cast<f32x4*>(km_l + tid * 4) = *reinterpret_cast<const f32x4*>(kmean + tid * 4); __syncthreads();
    float b1 = -3e38f, b2 = -3e38f, b3 = -3e38f; int i1 = -1, i2 = -1, i3 = -1;
#pragma unroll 1
    for (int n = 0; n < qblk; ++n) { float acc = 0.f;
#pragma unroll
      for (int d0 = 0; d0 < 8; ++d0) { const u32x4 w = *reinterpret_cast<const u32x4*>(&qr[d0]); const float* kp = km_l + n * 128 + d0 * 16 + hi * 8;
        const f32x4 k0 = *reinterpret_cast<const f32x4*>(kp), k1 = *reinterpret_cast<const f32x4*>(kp + 4);
        acc += blo(w.x) * k0[0] + bhi(w.x) * k0[1] + blo(w.y) * k0[2] + bhi(w.y) * k0[3] + blo(w.z) * k1[0] + bhi(w.z) * k1[1] + blo(w.w) * k1[2] + bhi(w.w) * k1[3]; }
      acc += __shfl_xor(acc, 32);
      if (acc > b1) { b3 = b2; i3 = i2; b2 = b1; i2 = i1; b1 = acc; i1 = n; } else if (acc > b2) { b3 = b2; i3 = i2; b2 = acc; i2 = n; } else if (acc > b3) { b3 = acc; i3 = n; } }
    sel = (i1 >= 0 ? 1u << i1 : 0u) | (i2 >= 0 ? 1u << i2 : 0u) | (i3 >= 0 ? 1u << i3 : 0u);
    asm volatile("" : "+v"(sel));
  }
  const char* Q_lds = lds + SHM_ATTN + 512; const int qrow = wid * QBLK + r32;
  if constexpr (QL) {
#pragma unroll
    for (int d0 = 0; d0 < 8; ++d0) *reinterpret_cast<bf16x8*>((char*)Q_lds + KSWZ(qrow, (d0 * 16 + hi * 8) * 2)) = qr[d0];
  }
#define QKT(P0, P1, KS) do { if constexpr (QL) qkt_l(P0, P1, KS, Q_lds, qrow, r32, hi); else qkt(P0, P1, KS, qr, r32, hi); } while (0)
  const int sr = tid >> 4, sc = (tid & 15) * 8, vst0 = v_st(sr, sc), vst1 = v_st(32 + sr, sc);
  const float* gk_l = (const float*)(lds + SHM_ATTN);
  if constexpr (MODE == 0) { if (tid < 128) ((float*)(lds + SHM_ATTN))[tid] = gk[tid]; __syncthreads(); }
  const int vb0 = (int)(uintptr_t)V_lds + v_rd_base(lane);
  struct { bf16x8 vs0, vs1, ks0, ks1; } sr_[2];
  const unsigned toff = (unsigned)(sr * LDK + sc) * 2u;
#define SLOAD(i, k0) do { const char* kb_ = (const char*)Kh + (size_t)(k0) * (size_t)(LDK * 2); \
    sr_[i].vs0 = *reinterpret_cast<const bf16x8*>(kb_ + VOFFB + toff); sr_[i].vs1 = *reinterpret_cast<const bf16x8*>(kb_ + (VOFFB + 32 * LDK * 2) + toff); \
    sr_[i].ks0 = *reinterpret_cast<const bf16x8*>(kb_ + toff); sr_[i].ks1 = *reinterpret_cast<const bf16x8*>(kb_ + (32 * LDK * 2) + toff); } while (0)
#define KN(x) ((MODE == 0) ? knorm8((x), gk_l + sc) : (x))
#define SWRITE(b, i) do { *(bf16x8*)((char*)V_lds + (b) * SHM_V + vst0) = sr_[i].vs0;          \
    *(bf16x8*)((char*)V_lds + (b) * SHM_V + vst1) = sr_[i].vs1; int kc = sc * 2;               \
    *(bf16x8*)((char*)K_lds + (b) * SHM_K + KSWZ(sr, kc)) = KN(sr_[i].ks0);                       \
    *(bf16x8*)((char*)K_lds + (b) * SHM_K + KSWZ(32 + sr, kc)) = KN(sr_[i].ks1); } while (0)
#define SWAIT() do { if constexpr (SD == 2) asm volatile("s_waitcnt vmcnt(4)" ::: "memory"); else asm volatile("s_waitcnt vmcnt(0)" ::: "memory"); } while (0)
#define RESC(a) do { if (__any((a) < 1.f)) { if (hi == 0) al_l[r32] = (a); asm volatile("s_waitcnt lgkmcnt(0)" ::: "memory"); \
    for (int d = 0; d < 4; ++d) for (int r = 0; r < 16; ++r) o[d][r] *= al_l[crow(r, hi)]; } } while (0)
#define MASK(P0, P1, tile) do { if constexpr (MODE == 1 && !ATT_NOMASK) { const int nb_ = (tile) >> 2; const float ninf_ = -__builtin_inff(); \
    if (nb_ < qblk) { if (!((sel >> nb_) & 1u)) { for (int r = 0; r < 16; ++r) { P0[r] = ninf_; P1[r] = ninf_; } } } \
    else { const int thr_ = rowthr - ((tile) & 3) * 64;     \
      for (int r = 0; r < 16; ++r) { const int c_ = (r & 3) + 8 * (r >> 2); if (c_ > thr_) P0[r] = ninf_; if (c_ + 32 > thr_) P1[r] = ninf_; } } } } while (0)
  const int rowthr = wid * 32 + r32 - 4 * hi;
  const int NT = seq / KVBLK;
  if constexpr (PIPE) {
  f32x16 pA0, pA1, pB0, pB1; float mnA, mnB, alA, alB; bf16x8 pa0, pa1, pa2, pa3;
  constexpr int SE = 0, SO = SD - 1;
  SLOAD(SE, 0); asm volatile("s_waitcnt vmcnt(0)" ::: "memory"); SWRITE(0, SE); __syncthreads();
  QKT(pA0, pA1, K_lds); MASK(pA0, pA1, 0); partialSM(pA0, pA1, m_reg, mnA, alA);
  SLOAD(SO, KVBLK); if constexpr (SD == 2) { if (2 < NT) SLOAD(SE, 2 * KVBLK); }
  SWAIT(); SWRITE(1, SO); __syncthreads();
  for (int j = 1; j + 1 < NT; j += 2) {
    SBAR(); QKT(pB0, pB1, (bf16*)((char*)K_lds + SHM_K)); MASK(pB0, pB1, j);
    finishSM(pA0, pA1, alA, l_reg, pa0, pa1, pa2, pa3); SBAR();
    SLOAD(SO, (j + SD) * KVBLK); SBAR();
    pv_d0(o, vb0, pa0, pa1, pa2, pa3); partialSM(pB0, pB1, m_reg, mnB, alB);
    __syncthreads(); SWAIT(); SWRITE(0, SE);
    RESC(alB); __syncthreads();
    SBAR(); QKT(pA0, pA1, K_lds); MASK(pA0, pA1, j + 1);
    finishSM(pB0, pB1, alB, l_reg, pa0, pa1, pa2, pa3); SBAR();
    if (SD == 1 || j + 3 < NT) SLOAD(SE, (j + 1 + SD) * KVBLK); SBAR();
    pv_d0(o, vb0 + (int)SHM_V, pa0, pa1, pa2, pa3); partialSM(pA0, pA1, m_reg, mnA, alA);
    __syncthreads(); SWAIT(); SWRITE(1, SO);
    RESC(alA); __syncthreads();
  }
  SBAR(); QKT(pB0, pB1, (bf16*)((char*)K_lds + SHM_K)); MASK(pB0, pB1, NT - 1);
  finishSM(pA0, pA1, alA, l_reg, pa0, pa1, pa2, pa3); SBAR();
  pv_d0(o, vb0, pa0, pa1, pa2, pa3); partialSM(pB0, pB1, m_reg, mnB, alB);
  __syncthreads(); RESC(alB);
  finishSM(pB0, pB1, alB, l_reg, pa0, pa1, pa2, pa3); SBAR();
  pv_d0(o, vb0 + (int)SHM_V, pa0, pa1, pa2, pa3);
  } else {
    f32x16 p0, p1; float mn, al; bf16x8 pa0, pa1, pa2, pa3;
#define TILE(buf, t) do { SBAR(); QKT(p0, p1, (bf16*)((char*)K_lds + (buf) * SHM_K)); MASK(p0, p1, (t)); \
      partialSM(p0, p1, m_reg, mn, al); finishSM(p0, p1, al, l_reg, pa0, pa1, pa2, pa3); RESC(al); SBAR(); \
      pv_d0(o, vb0 + (buf) * (int)SHM_V, pa0, pa1, pa2, pa3); } while (0)
    SLOAD(0, 0); asm volatile("s_waitcnt vmcnt(0)" ::: "memory"); SWRITE(0, 0); __syncthreads();
    SLOAD(1, KVBLK);
#pragma unroll 1
    for (int t = 0; t < NT; t += 2) {
      if (t + 2 < NT) SLOAD(0, (t + 2) * KVBLK);
      TILE(0, t);
      SWRITE(1, 1); __syncthreads();
      if (t + 3 < NT) SLOAD(1, (t + 3) * KVBLK);
      TILE(1, t + 1);
      if (t + 2 < NT) SWRITE(0, 0);
      __syncthreads();
    }
#undef TILE
  }
  if (hi == 0) li_l[r32] = l_reg; asm volatile("s_waitcnt lgkmcnt(0)" ::: "memory");
  float rli[16];
#pragma unroll
  for (int r = 0; r < 16; ++r) rli[r] = __builtin_amdgcn_rcpf(li_l[crow(r, hi)]);
  bf16* Ow = Ob + (long)(wid * QBLK) * LDO;
#pragma unroll
  for (int r = 0; r < 16; ++r) { int orow = crow(r, hi);
    for (int d0 = 0; d0 < 4; ++d0) Ow[(long)orow * LDO + d0 * 32 + r32] = (bf16)(cvtpk(o[d0][r] * rli[r], 0.f) & 0xffffu); }
  __syncthreads();
#undef SLOAD
#undef KN
#undef SWRITE
#undef SWAIT
#undef RESC
#undef MASK
#undef QKT
}
#undef KSWZ
#undef SBAR
}
struct Args { const float* in[25]; float* out; unsigned char* ws; int lo1, hi1, lo2, hi2; };

__device__ __forceinline__ void transpose_item(const float* W, int K, int N, bf16* WT, int dst_row0, LAS float* scr, int k0, int n0, int lane) {
    const int nn = n0 + (lane & 31); const bool ok = nn < N;
#pragma unroll 8
    for (int i = 0; i < 32; ++i) { const int kk = 2 * i + (lane >> 5); scr[kk * 33 + (lane & 31)] = ok ? W[(size_t)(k0 + kk) * N + nn] : 0.f; }
    LDS_WAIT(); asm volatile("" ::: "memory");
    const int c = lane & 7;
#pragma unroll
    for (int j = 0; j < 4; ++j) { const int n = (lane >> 3) + 8 * j; const LAS float* s = scr + (8 * c) * 33 + n;
        v4u o; o.x = pk2(s[0 * 33], s[1 * 33]); o.y = pk2(s[2 * 33], s[3 * 33]); o.z = pk2(s[4 * 33], s[5 * 33]); o.w = pk2(s[6 * 33], s[7 * 33]);
        *(v4u*)(WT + (size_t)(dst_row0 + n) * K + k0 + 8 * c) = o; }
    LDS_WAIT(); asm volatile("" ::: "memory");
}

#define XB_TMO      128
#define XB_XCNT(j)  (256  + 64 * (j))
#define XB_XSUB(j)  (1280 + 64 * (j))
#define XB_XGEN(j)  (2304 + 64 * (j))
#define XB_TOP      3328
#define XB_TOPGEN   3392
#define XCD_BAR_WORDS 3456
#define XB_SPIN_CAP (1u << 18)

__device__ __forceinline__ unsigned xb_ld(unsigned* p)              { return __hip_atomic_load(p, __ATOMIC_RELAXED, __HIP_MEMORY_SCOPE_AGENT); }
__device__ __forceinline__ unsigned xb_add(unsigned* p, unsigned v) { return __hip_atomic_fetch_add(p, v, __ATOMIC_RELAXED, __HIP_MEMORY_SCOPE_AGENT); }
__device__ __forceinline__ unsigned xb_xcc_id() { return (unsigned)__builtin_amdgcn_s_getreg((3 << 11) | 20) & 0xFu; }
#define XB_SPIN(cond, bar) do { unsigned _sp = 0; while (cond) { __builtin_amdgcn_s_sleep(1); \
    if ((++_sp & 255u) == 0u) { if (xb_ld(&(bar)[XB_TMO])) break; if (_sp > XB_SPIN_CAP) { atomicAdd(&(bar)[XB_TMO], 1u); break; } } } } while (0)

struct XcdBarrier {
    unsigned* bar; unsigned x;
    volatile LAS unsigned* st;
};

__device__ __forceinline__ XcdBarrier xcd_barrier_post(unsigned* bar, volatile LAS unsigned* st) {
    XcdBarrier b; b.bar = bar; b.x = xb_xcc_id(); b.st = st;
    if (threadIdx.x == 0) (void)xb_add(&bar[XB_XCNT(b.x)], 1u);
    return b;
}
__device__ __forceinline__ void xcd_barrier_complete(unsigned* bar, unsigned x, unsigned& nloc, unsigned& nx) {
    const unsigned G = gridDim.x * gridDim.y * gridDim.z;
    unsigned sum, cnt, mine, sp = 0u;
    for (;;) {
        sum = 0u; cnt = 0u; mine = 0u;
#pragma unroll
        for (unsigned j = 0; j < 16; ++j) { const unsigned c = xb_ld(&bar[XB_XCNT(j)]); sum += c; cnt += (c > 0u) ? 1u : 0u; mine = (j == x) ? c : mine; }
        if (sum == G) break;
        __builtin_amdgcn_s_sleep(1);
        if ((++sp & 255u) == 0u) { if (xb_ld(&bar[XB_TMO])) break; if (sp > XB_SPIN_CAP) { atomicAdd(&bar[XB_TMO], 1u); break; } }
    }
    nloc = mine > 0u ? mine : 1u; nx = cnt > 0u ? cnt : 1u;
}

__device__ __forceinline__ void xcd_barrier(const XcdBarrier& b) {
    asm volatile("s_waitcnt vmcnt(0)" ::: "memory");
    __syncthreads();
    if (threadIdx.x == 0) {
        unsigned* bar = b.bar;
        __builtin_amdgcn_s_waitcnt(0);
        unsigned nloc = b.st[0], nx = b.st[1];
        if (nloc == 0u) { xcd_barrier_complete(bar, b.x, nloc, nx); b.st[0] = nloc; b.st[1] = nx; }
        const unsigned old = xb_add(&bar[XB_XSUB(b.x)], 1u);
        const unsigned gen = old / nloc;
        if (old + 1u == (gen + 1u) * nloc) {
            __builtin_amdgcn_fence(__ATOMIC_RELEASE, "agent");
            asm volatile("s_waitcnt vmcnt(0)" ::: "memory");
            const unsigned og = xb_add(&bar[XB_TOP], 1u);
            const unsigned tg = og / nx;
            if (og + 1u == (tg + 1u) * nx) xb_add(&bar[XB_TOPGEN], 1u);
            else XB_SPIN(xb_ld(&bar[XB_TOPGEN]) == tg, bar);
            __builtin_amdgcn_fence(__ATOMIC_ACQUIRE, "agent");
            xb_add(&bar[XB_XGEN(b.x)], 1u);
            asm volatile("s_waitcnt vmcnt(0)" ::: "memory");
        } else {
            XB_SPIN(xb_ld(&bar[XB_XGEN(b.x)]) == gen, bar);
            __builtin_amdgcn_fence(__ATOMIC_ACQUIRE, "agent");
            asm volatile("s_waitcnt vmcnt(0)" ::: "memory");
        }
    }
    __syncthreads();
}
struct Item { const float* W; bf16* WT; const float* g; int K, N, k0, n0, drow; };
constexpr int IT_GU = (D_ / 64) * (FF_ / 128), IT_DN = (FF_ / 64) * (D_ / 128), IT_IN = (D_ / 64) * (NINP / 128), IT_OUT = (D_ / 64) * (D_ / 128), IT_Q = (D_ / 64) * (512 / 128), IT_KV = (D_ / 64) * (1024 / 128), IT_O = (512 / 64) * (D_ / 128);
constexpr int IL_W1GU = 0, IL_W1D = 2 * IT_GU, IL_WIN = IL_W1D + IT_DN, IL_WOUT = IL_WIN + IT_IN, IL_WQ = IL_WOUT + IT_OUT, IL_WKV = IL_WQ + IT_Q, IL_WO = IL_WKV + IT_KV, IL_W2GU = IL_WO + IT_O, IL_W2D = IL_W2GU + 2 * IT_GU, IL_END = IL_W2D + IT_DN;
__device__ __forceinline__ void decode_item(int r, const Args& a, unsigned char* ws, Item& it) {
    const float* W; bf16* WT; const float* gg = nullptr; int K, N, NP, mode = 0;
    if (r < IL_W1D) { const bool up = r >= IT_GU; r -= up ? IT_GU : 0; W = a.in[up ? 4 : 3]; gg = a.in[2]; WT = (bf16*)(ws + WS_W1GU); K = D_; N = FF_; NP = FF_; mode = up ? 2 : 1; }
    else if (r < IL_WIN) { r -= IL_W1D; W = a.in[5]; WT = (bf16*)(ws + WS_W1D); K = FF_; N = D_; NP = D_; }
    else if (r < IL_WOUT) { r -= IL_WIN; W = a.in[7]; gg = a.in[6]; WT = (bf16*)(ws + WS_WIN); K = D_; N = NIN; NP = NINP; }
    else if (r < IL_WQ) { r -= IL_WOUT; W = a.in[13]; WT = (bf16*)(ws + WS_WOUT); K = D_; N = D_; NP = D_; }
    else if (r < IL_WKV) { r -= IL_WQ; W = a.in[16]; gg = a.in[14]; WT = (bf16*)(ws + WS_WQ); K = D_; N = 512; NP = 512; }
    else if (r < IL_WO) { r -= IL_WKV; W = a.in[17]; WT = (bf16*)(ws + WS_WKV); K = D_; N = 1024; NP = 1024; }
    else if (r < IL_W2GU) { r -= IL_WO; W = a.in[18]; WT = (bf16*)(ws + WS_WO); K = 512; N = D_; NP = D_; }
    else if (r < IL_W2D) { r -= IL_W2GU; const bool up = r >= IT_GU; r -= up ? IT_GU : 0; W = a.in[up ? 23 : 22]; gg = a.in[21]; WT = (bf16*)(ws + WS_W2GU); K = D_; N = FF_; NP = FF_; mode = up ? 2 : 1; }
    else { r -= IL_W2D; W = a.in[24]; WT = (bf16*)(ws + WS_W2D); K = FF_; N = D_; NP = D_; }
    const int nblk = NP / 128, kb = r / nblk, nb = r - kb * nblk, n0 = nb * 128;
    it.W = W; it.WT = WT; it.g = gg; it.K = K; it.N = N; it.k0 = kb * 64; it.n0 = n0;
    it.drow = mode ? nb * 256 + (mode == 2 ? 128 : 0) : n0;
}
__device__ __forceinline__ void item_convert(const Item& it, int lane) {
    const int nn = it.n0 + 2 * lane; const bool ok = nn < it.N;
    const f32x2* p = (const f32x2*)(it.W + (size_t)it.k0 * it.N + (ok ? nn : 0)); const size_t st = (size_t)(it.N >> 1);
    f32x2 v[64];
#pragma unroll
    for (int i = 0; i < 64; ++i) v[i] = p[i * st];
    if (!ok) {
#pragma unroll
        for (int i = 0; i < 64; ++i) v[i] = (f32x2){0.f, 0.f}; }
    if (it.g) {
#pragma unroll
        for (int i = 0; i < 64; ++i) v[i] = v[i] * it.g[it.k0 + i]; }
    int dr = it.drow + 2 * lane;
    if (it.N == NIN) dr = nn < 3072 ? nn : (nn < 3088 ? 6144 + (nn - 3072) : (nn < NIN ? nn - 16 : nn));
    bf16* o0 = it.WT + (size_t)dr * it.K + it.k0; bf16* o1 = o0 + it.K;
#pragma unroll
    for (int j = 0; j < 8; ++j) {
        v4u x0, x1;
        x0.x = pg8::cvt_pk_bf16(v[8 * j][0], v[8 * j + 1][0]); x0.y = pg8::cvt_pk_bf16(v[8 * j + 2][0], v[8 * j + 3][0]); x0.z = pg8::cvt_pk_bf16(v[8 * j + 4][0], v[8 * j + 5][0]); x0.w = pg8::cvt_pk_bf16(v[8 * j + 6][0], v[8 * j + 7][0]);
        x1.x = pg8::cvt_pk_bf16(v[8 * j][1], v[8 * j + 1][1]); x1.y = pg8::cvt_pk_bf16(v[8 * j + 2][1], v[8 * j + 3][1]); x1.z = pg8::cvt_pk_bf16(v[8 * j + 4][1], v[8 * j + 5][1]); x1.w = pg8::cvt_pk_bf16(v[8 * j + 6][1], v[8 * j + 7][1]);
        *(v4u*)(o0 + 8 * j) = x0; *(v4u*)(o1 + 8 * j) = x1; }
}
__device__ __forceinline__ void convert_range(int lo, int hi, int first, int stride, const Args& a, unsigned char* ws, LAS float* scr, int lane) {
#pragma unroll 1
    for (int r = lo + first; r < hi; r += stride) { Item it; decode_item(r, a, ws, it); item_convert(it, lane); }
}

template <bool KNORM>
__device__ __forceinline__ void attn_block(const bf16* K, const bf16* V, int ld, int limit, float q0, float q1, float& m, float& l, float& o0, float& o1, LAS float* sc, int lane) {
    float bm = -1e30f;
    limit = __builtin_amdgcn_readfirstlane(limit);
    for (int key = 0; key < limit; ++key) {
        const unsigned kk = *(const unsigned*)(K + (size_t)key * ld + 2 * lane);
        const float k0 = bflo(kk), k1 = bfhi(kk);
        float s = wave_sum(q0 * k0 + q1 * k1);
        if (KNORM) { const float ss = wave_sum(k0 * k0 + k1 * k1); s *= rsqrtf(ss * (1.0f / 128.0f) + EPS); }
        if (lane == 0) sc[key] = s;
        bm = fmaxf(bm, s);
    }
    const float mn = fmaxf(m, bm), corr = __expf(m - mn);
    l *= corr; o0 *= corr; o1 *= corr;
    LDS_WAIT();
    for (int key = 0; key < limit; ++key) {
        const float p = __expf(sc[key] - mn); l += p;
        const unsigned vv = *(const unsigned*)(V + (size_t)key * ld + 2 * lane);
        o0 += p * bflo(vv); o1 += p * bfhi(vv);
    }
    LDS_WAIT();
    m = mn;
}

typedef short bf16x8_t __attribute__((ext_vector_type(8)));
constexpr int KTS = 72, QS = 136;
constexpr size_t WS_UPDT = WS_W1GU, WS_DEC = WS_KMEAN + 512 * 1024;
__device__ __forceinline__ float logsig(float x) { return fminf(x, 0.f) - log1pf(__expf(-fabsf(x))); }
__device__ __forceinline__ void load_vt(const bf16* U, size_t row0, int vcol, LAS bf16* VTw, int lane) {
    const v4u* p = (const v4u*)(U + (row0 + lane) * NINP + vcol);
#pragma unroll
    for (int c = 0; c < 4; ++c) { const v4u x = p[c]; const unsigned w[4] = {x.x, x.y, x.z, x.w};
#pragma unroll
        for (int e = 0; e < 4; ++e) { VTw[(c * 8 + 2 * e) * KTS + lane] = (bf16)(w[e] & 0xffffu); VTw[(c * 8 + 2 * e + 1) * KTS + lane] = (bf16)(w[e] >> 16); } }
}
__device__ __forceinline__ void gla_a(int task, const bf16* U, const float* LR, const float* w2, const float* b2, float* BCUM, float* DEC, float* UPDT, LAS unsigned char* lds, int tid) {
    const int lane = tid & 63, wave = tid >> 6, l15 = lane & 15, lq = lane >> 4;
    const int bh = task >> 6, n = task & 63, b = bh >> 2, h = bh & 3; const size_t row0 = (size_t)b * T_ + n * 64;
    LAS bf16* KT = (LAS bf16*)lds;
    LAS float* segtot = (LAS float*)(lds + 18432);
    LAS bf16* VTw = (LAS bf16*)(lds + 20480 + wave * 4608);
    const int d = tid & 127, ig = tid >> 7;
    float w2c[16];
#pragma unroll
    for (int j = 0; j < 16; ++j) w2c[j] = w2[j * 512 + h * 128 + d];
    const float bias = b2[h * 128 + d];
    float c[16]; float run = 0.f;
#pragma unroll
    for (int ii = 0; ii < 16; ++ii) { const f32x4* lr = (const f32x4*)(LR + (row0 + ig * 16 + ii) * 16); float acc = bias;
#pragma unroll
        for (int j4 = 0; j4 < 4; ++j4) { const f32x4 v = lr[j4]; acc += v[0] * w2c[4 * j4] + v[1] * w2c[4 * j4 + 1] + v[2] * w2c[4 * j4 + 2] + v[3] * w2c[4 * j4 + 3]; }
        run += logsig(acc) * (1.0f / 16.0f); c[ii] = run; }
    segtot[ig * 128 + d] = run;
    load_vt(U, row0, GV_OFF + h * 256 + 32 * wave, VTw, lane);
    __syncthreads();
    const float s0 = segtot[d], s1 = segtot[128 + d], s2 = segtot[256 + d], s3 = segtot[384 + d];
    const float pre = ((ig > 0 ? s0 : 0.f) + (ig > 1 ? s1 : 0.f)) + (ig > 2 ? s2 : 0.f), blast = ((s0 + s1) + s2) + s3;
    unsigned short kraw[16];
#pragma unroll
    for (int ii = 0; ii < 16; ++ii) kraw[ii] = U[(row0 + ig * 16 + ii) * NINP + GK_OFF + h * 128 + d];
    asm volatile("" ::: "memory");
    unsigned pk[8];
#pragma unroll
    for (int ii = 0; ii < 16; ii += 2) { float kt[2];
#pragma unroll
        for (int e = 0; e < 2; ++e) { const size_t row = row0 + ig * 16 + ii + e; const float bc = pre + c[ii + e];
            BCUM[row * 512 + h * 128 + d] = bc;
            kt[e] = bflo((unsigned)kraw[ii + e]) * __expf(blast - bc); }
        pk[ii >> 1] = pk2(kt[0], kt[1]); }
    *(LAS v4u*)(KT + d * KTS + ig * 16) = (v4u){pk[0], pk[1], pk[2], pk[3]};
    *(LAS v4u*)(KT + d * KTS + ig * 16 + 8) = (v4u){pk[4], pk[5], pk[6], pk[7]};
    if (ig == 0) DEC[(size_t)task * 128 + d] = __expf(blast);
    __syncthreads();
    f32x4 acc[8][2];
#pragma unroll
    for (int dt = 0; dt < 8; ++dt) { acc[dt][0] = (f32x4){0.f, 0.f, 0.f, 0.f}; acc[dt][1] = (f32x4){0.f, 0.f, 0.f, 0.f}; }
#pragma unroll
    for (int ks = 0; ks < 2; ++ks) {
        const bf16x8_t B0 = *(const LAS bf16x8_t*)(VTw + (l15) * KTS + ks * 32 + 8 * lq), B1 = *(const LAS bf16x8_t*)(VTw + (16 + l15) * KTS + ks * 32 + 8 * lq);
#pragma unroll
        for (int dt = 0; dt < 8; ++dt) { const bf16x8_t A = *(const LAS bf16x8_t*)(KT + (dt * 16 + l15) * KTS + ks * 32 + 8 * lq);
            acc[dt][0] = __builtin_amdgcn_mfma_f32_16x16x32_bf16(A, B0, acc[dt][0], 0, 0, 0); acc[dt][1] = __builtin_amdgcn_mfma_f32_16x16x32_bf16(A, B1, acc[dt][1], 0, 0, 0); } }
    float* up = UPDT + (size_t)task * 32768;
#pragma unroll
    for (int dt = 0; dt < 8; ++dt)
#pragma unroll
        for (int nt = 0; nt < 2; ++nt) *(f32x4*)(up + (32 * wave + nt * 16 + l15) * 128 + dt * 16 + lq * 4) = acc[dt][nt];
    __syncthreads();
}
__device__ __forceinline__ void gla_scan(int idx, const float* __restrict__ UPDT, const float* __restrict__ DEC, bf16* __restrict__ SPT) {
    const int d4 = idx & 31, v = (idx >> 5) & 255, bh = idx >> 13;
    f32x4 S = (f32x4){0.f, 0.f, 0.f, 0.f};
    const size_t e0 = (size_t)v * 128 + d4 * 4;
#pragma unroll 1
    for (int n0 = 0; n0 < 64; n0 += 16) {
        f32x4 u[16], dc[16];
#pragma unroll
        for (int j = 0; j < 16; ++j) { const size_t task = (size_t)bh * 64 + n0 + j; u[j] = *(const f32x4*)(UPDT + task * 32768 + e0); dc[j] = *(const f32x4*)(DEC + task * 128 + d4 * 4); }
        asm volatile("" ::: "memory");
#pragma unroll
        for (int j = 0; j < 16; ++j) { const size_t task = (size_t)bh * 64 + n0 + j;
            v2u pk; pk.x = pg8::cvt_pk_bf16(S[0], S[1]); pk.y = pg8::cvt_pk_bf16(S[2], S[3]); *(v2u*)(SPT + task * 32768 + e0) = pk;
            S = dc[j] * S + u[j]; }
    }
}
__device__ __forceinline__ void gla_c(int task, const bf16* U, const float* BCUM, const bf16* SPT, const float* gout, bf16* MIX, LAS unsigned char* lds, int tid) {
    const int lane = tid & 63, wave = tid >> 6, l15 = lane & 15, lq = lane >> 4;
    const int bh = task >> 6, n = task & 63, b = bh >> 2, h = bh & 3; const size_t row0 = (size_t)b * T_ + n * 64;
    LAS bf16* QD = (LAS bf16*)lds;
    LAS bf16* KI = (LAS bf16*)(lds + 17408);
    LAS bf16* ATT = (LAS bf16*)(lds + 34816);
    LAS float* SSQ = (LAS float*)(lds + 44032);
    LAS bf16* VTw = (LAS bf16*)(lds + 46080 + wave * 4608);
    const int d = tid & 127, ig = tid >> 7;
    { v4u q8[2], k8[2]; f32x4 bc0[2], bc1[2];
#pragma unroll
      for (int rep = 0; rep < 2; ++rep) { const int idx = tid + NTHR * rep, i = idx >> 4, c8 = (idx & 15) * 8; const size_t row = row0 + i;
          q8[rep] = *(const v4u*)(U + row * NINP + GQ_OFF + h * 128 + c8); k8[rep] = *(const v4u*)(U + row * NINP + GK_OFF + h * 128 + c8);
          bc0[rep] = *(const f32x4*)(BCUM + row * 512 + h * 128 + c8); bc1[rep] = *(const f32x4*)(BCUM + row * 512 + h * 128 + c8 + 4); }
#pragma unroll
      for (int rep = 0; rep < 2; ++rep) { const int idx = tid + NTHR * rep, i = idx >> 4, c8 = (idx & 15) * 8;
          const float bc[8] = {bc0[rep][0], bc0[rep][1], bc0[rep][2], bc0[rep][3], bc1[rep][0], bc1[rep][1], bc1[rep][2], bc1[rep][3]};
          const unsigned qw[4] = {q8[rep].x, q8[rep].y, q8[rep].z, q8[rep].w}, kw[4] = {k8[rep].x, k8[rep].y, k8[rep].z, k8[rep].w};
          unsigned qo[4], ko[4];
#pragma unroll
          for (int e = 0; e < 4; ++e) { const float e0 = __expf(bc[2 * e]), e1 = __expf(bc[2 * e + 1]);
              qo[e] = pg8::cvt_pk_bf16(bflo(qw[e]) * 0.08838834764831845f * e0, bfhi(qw[e]) * 0.08838834764831845f * e1);
              ko[e] = pg8::cvt_pk_bf16(bflo(kw[e]) * __builtin_amdgcn_rcpf(e0), bfhi(kw[e]) * __builtin_amdgcn_rcpf(e1)); }
          *(LAS v4u*)(QD + i * QS + c8) = (v4u){qo[0], qo[1], qo[2], qo[3]}; *(LAS v4u*)(KI + i * QS + c8) = (v4u){ko[0], ko[1], ko[2], ko[3]}; } }
    load_vt(U, row0, GV_OFF + h * 256 + 32 * wave, VTw, lane);
    bf16x8_t sp[2][4];
#pragma unroll
    for (int vt = 0; vt < 2; ++vt)
#pragma unroll
        for (int ks = 0; ks < 4; ++ks) sp[vt][ks] = *(const bf16x8_t*)(SPT + (size_t)task * 32768 + (32 * wave + vt * 16 + l15) * 128 + ks * 32 + 8 * lq);
    v2u rr8[4][2];
#pragma unroll
    for (int it = 0; it < 4; ++it)
#pragma unroll
        for (int vt = 0; vt < 2; ++vt) rr8[it][vt] = *(const v2u*)(U + (row0 + it * 16 + l15) * NINP + GR_OFF + h * 256 + 32 * wave + vt * 16 + lq * 4);
    __syncthreads();
#pragma unroll
    for (int tt = 0; tt < 2; ++tt) { const int tile = 2 * wave + tt, it = tile >> 2, jt = tile & 3;
        f32x4 sv = (f32x4){0.f, 0.f, 0.f, 0.f};
        if (jt <= it) {
#pragma unroll
            for (int ks = 0; ks < 4; ++ks) { const bf16x8_t A = *(const LAS bf16x8_t*)(KI + (jt * 16 + l15) * QS + ks * 32 + 8 * lq), B = *(const LAS bf16x8_t*)(QD + (it * 16 + l15) * QS + ks * 32 + 8 * lq);
                sv = __builtin_amdgcn_mfma_f32_16x16x32_bf16(A, B, sv, 0, 0, 0); } }
        const int i = it * 16 + l15, j0 = jt * 16 + lq * 4;
#pragma unroll
        for (int r = 0; r < 4; ++r) if (j0 + r > i) sv[r] = 0.f;
        v2u pk; pk.x = pk2(sv[0], sv[1]); pk.y = pk2(sv[2], sv[3]);
        *(LAS v2u*)(ATT + i * KTS + j0) = pk; }
    __syncthreads();
    f32x4 acc[2][4];
#pragma unroll
    for (int it = 0; it < 4; ++it) { acc[0][it] = (f32x4){0.f, 0.f, 0.f, 0.f}; acc[1][it] = (f32x4){0.f, 0.f, 0.f, 0.f};
#pragma unroll
        for (int ks = 0; ks < 4; ++ks) { const bf16x8_t B = *(const LAS bf16x8_t*)(QD + (it * 16 + l15) * QS + ks * 32 + 8 * lq);
            acc[0][it] = __builtin_amdgcn_mfma_f32_16x16x32_bf16(sp[0][ks], B, acc[0][it], 0, 0, 0); acc[1][it] = __builtin_amdgcn_mfma_f32_16x16x32_bf16(sp[1][ks], B, acc[1][it], 0, 0, 0); }
#pragma unroll
        for (int ks = 0; ks < 2; ++ks) { const bf16x8_t B = *(const LAS bf16x8_t*)(ATT + (it * 16 + l15) * KTS + ks * 32 + 8 * lq);
            const bf16x8_t A0 = *(const LAS bf16x8_t*)(VTw + (l15) * KTS + ks * 32 + 8 * lq), A1 = *(const LAS bf16x8_t*)(VTw + (16 + l15) * KTS + ks * 32 + 8 * lq);
            acc[0][it] = __builtin_amdgcn_mfma_f32_16x16x32_bf16(A0, B, acc[0][it], 0, 0, 0); acc[1][it] = __builtin_amdgcn_mfma_f32_16x16x32_bf16(A1, B, acc[1][it], 0, 0, 0); } }
#pragma unroll
    for (int it = 0; it < 4; ++it) { float ssq = 0.f;
#pragma unroll
        for (int vt = 0; vt < 2; ++vt) { const f32x4 x = acc[vt][it]; ssq += (x[0] * x[0] + x[1] * x[1]) + (x[2] * x[2] + x[3] * x[3]); }
        ssq += __shfl_xor(ssq, 16); ssq += __shfl_xor(ssq, 32);
        if (lq == 0) SSQ[wave * 64 + it * 16 + l15] = ssq; }
    __syncthreads();
#pragma unroll
    for (int it = 0; it < 4; ++it) { const int i = it * 16 + l15; float tot = 0.f;
#pragma unroll
        for (int w = 0; w < 8; ++w) tot += SSQ[w * 64 + i];
        const float rinv = rsqrtf(tot * (1.0f / 256.0f) + EPS); const size_t row = row0 + i;
#pragma unroll
        for (int vt = 0; vt < 2; ++vt) { const int v = 32 * wave + vt * 16 + lq * 4;
            const v2u rr = rr8[it][vt]; const f32x4 g = *(const f32x4*)(gout + v); const f32x4 x = acc[vt][it];
            v2u pk; pk.x = pk2(x[0] * rinv * g[0] * pg8::silu_f(bflo(rr.x)), x[1] * rinv * g[1] * pg8::silu_f(bfhi(rr.x)));
            pk.y = pk2(x[2] * rinv * g[2] * pg8::silu_f(bflo(rr.y)), x[3] * rinv * g[3] * pg8::silu_f(bfhi(rr.y)));
            *(v2u*)(MIX + row * D_ + h * 256 + v) = pk; } }
    __syncthreads();
}

__global__ void __launch_bounds__(NTHR, 2) hymba_fwd(Args a) {
    extern __shared__ __attribute__((aligned(16))) unsigned char lds_raw[];
    LAS unsigned char* lds = (LAS unsigned char*)lds_raw;
    cg::grid_group grid = cg::this_grid();
    const int tid = threadIdx.x, lane = tid & 63, wave = __builtin_amdgcn_readfirstlane(tid >> 6);
    const int G = gridDim.x, gw = blockIdx.x * NWAVES + wave, NGW = G * NWAVES;
    unsigned char* ws = a.ws;
    volatile LAS unsigned* xst = (volatile LAS unsigned*)(lds + LDS_BYTES - 64);
    if (tid < 16) xst[tid] = 0u;
    __syncthreads();
    const XcdBarrier bar = xcd_barrier_post((unsigned*)ws, xst);
    const float* x = a.in[0]; float* out = a.out;
    bf16 *W1GU = (bf16*)(ws + WS_W1GU), *W1D = (bf16*)(ws + WS_W1D), *W2GU = (bf16*)(ws + WS_W2GU), *W2D = (bf16*)(ws + WS_W2D), *WIN = (bf16*)(ws + WS_WIN),
         *WOUT = (bf16*)(ws + WS_WOUT), *WQ = (bf16*)(ws + WS_WQ), *WKV = (bf16*)(ws + WS_WKV), *WO = (bf16*)(ws + WS_WO);
    bf16 *XN = (bf16*)(ws + WS_XN), *MEMN = (bf16*)(ws + WS_MEMN), *ACT = (bf16*)(ws + WS_ACT), *U = (bf16*)(ws + WS_ACT), *XQ = (bf16*)(ws + WS_XQ), *XO = (bf16*)(ws + WS_XO),
         *MKV = (bf16*)(ws + WS_MKV), *MIX = (bf16*)(ws + WS_MIX);
    float *SS = (float*)(ws + WS_SS), *ORAW = (float*)(ws + WS_XN), *LR = (float*)(ws + WS_LR), *LA = (float*)(ws + WS_LA), *KMEAN = (float*)(ws + WS_KMEAN);
    float *UPDT = (float*)(ws + WS_UPDT), *DEC = (float*)(ws + WS_DEC); bf16* SPT = (bf16*)(ws + WS_SPT);
#define IN(k) (a.lo1 <= (k) && (k) < a.hi1)
#define SEAM(k) do { if (a.lo1 <= (k) && (k) < a.hi1 && ((k) + 1 < a.hi1 || a.lo2 < a.hi2)) { if (a.hi2 < 0) grid.sync(); else xcd_barrier(bar); } } while (0)

    if (IN(0)) {
        LAS float* scr = (LAS float*)(lds + wave * 16384);
        convert_range(IL_W1GU, IL_W1D, gw, NGW, a, ws, scr, lane);
        if (gw >= 768) convert_range(IL_WOUT, IL_W2GU, gw - 768, NGW - 768, a, ws, scr, lane);
        const float* g1 = a.in[2];
        for (int m = gw; m < M_; m += NGW) {
            const f32x4* xr = (const f32x4*)(x + (size_t)m * D_) + lane; f32x4 v[8]; float ss = 0.f;
#pragma unroll
            for (int j = 0; j < 8; ++j) { v[j] = xr[64 * j]; ss += (v[j][0] * v[j][0] + v[j][1] * v[j][1]) + (v[j][2] * v[j][2] + v[j][3] * v[j][3]); }
            ss = wave_sum(ss);
#pragma unroll
            for (int j = 0; j < 8; ++j) { const f32x4 w = v[j]; v2u pk; pk.x = pk2(w[0], w[1]); pk.y = pk2(w[2], w[3]);
                *(v2u*)(XN + (size_t)m * D_ + 4 * lane + 256 * j) = pk; }
            if (lane < 32) SS[(size_t)m * 32 + lane] = (lane == 0) ? ss : 0.f;
        }
        const float* gm = a.in[15]; const float* mem = a.in[1];
        for (int m = gw; m < MM_; m += NGW) {
            const f32x4* xr = (const f32x4*)(mem + (size_t)m * D_) + lane; f32x4 v[8]; float ss = 0.f;
#pragma unroll
            for (int j = 0; j < 8; ++j) { v[j] = xr[64 * j]; ss += (v[j][0] * v[j][0] + v[j][1] * v[j][1]) + (v[j][2] * v[j][2] + v[j][3] * v[j][3]); }
            const float rs = rsqrtf(wave_sum(ss) * (1.0f / D_) + EPS);
#pragma unroll
            for (int j = 0; j < 8; ++j) { const f32x4 gv = ((const f32x4*)gm)[lane + 64 * j]; const f32x4 w = v[j] * gv * rs; v2u pk; pk.x = pk2(w[0], w[1]); pk.y = pk2(w[2], w[3]);
                *(v2u*)(MEMN + (size_t)m * D_ + 4 * lane + 256 * j) = pk; }
        }
        __syncthreads();
    }
    SEAM(0);
#ifdef PROBE_SYNCS
    for (int i_ = 0; i_ < PROBE_SYNCS; ++i_) xcd_barrier(bar);
#endif
    if (IN(1)) {
        pg8::Gemm g{XN, W1GU, M_, NGU, D_}; pg8::StaticOrder S; S.init(M_, NGU, G, (int)blockIdx.x);
        pg8::EpiSwiGLU E{ACT, FF_, SS};
        pg8::gemm_phase<pg8::EpiSwiGLU, pg8::StaticOrder, true, true>(lds, g, S, E);
        if ((int)blockIdx.x >= 128) convert_range(IL_W1D, IL_WOUT, ((int)blockIdx.x - 128) * NWAVES + wave, (G - 128) * NWAVES, a, ws, (LAS float*)(lds + wave * 16384), lane);
    }
    SEAM(1);
    if (IN(2)) {
        pg8::Gemm g{ACT, W1D, M_, D_, FF_}; pg8::StaticOrder S; S.init(M_, D_, G, (int)blockIdx.x);
        pg8::EpiRes2<false, false> E{x, XN, D_, 0.5f, SS};
        pg8::gemm_phase<pg8::EpiRes2<false, false>, pg8::StaticOrder, true, true>(lds, g, S, E);
    }
    SEAM(2);
    if (IN(3)) {
        pg8::Gemm g{XN, WIN, M_, NU, D_}; pg8::StaticOrder S; S.init(M_, NU, G, (int)blockIdx.x);
        pg8::EpiScale<false> E{U, NINP, SS, nullptr};
        pg8::gemm_phase<pg8::EpiScale<false>, pg8::StaticOrder, true, true>(lds, g, S, E);
    }
    SEAM(3);
    if (IN(4)) {
        const float* w2 = a.in[8]; const float* b2 = a.in[9];
        {
            const bf16* WLR = WIN + (size_t)NU * D_; const int l15 = lane & 15, lq = lane >> 4;
            LAS float* lrp = (LAS float*)lds;
            LAS float* rsl = (LAS float*)(lds + 16384);
            for (int rb = blockIdx.x; rb < M_ / 32; rb += G) { const size_t row0 = (size_t)rb * 32;
                f32x4 la[2] = {(f32x4){0.f, 0.f, 0.f, 0.f}, (f32x4){0.f, 0.f, 0.f, 0.f}};
#pragma unroll
                for (int half = 0; half < 2; ++half) { bf16x8_t Bf[4], Af[4][2];
#pragma unroll
                    for (int kk = 0; kk < 4; ++kk) { const int ko = (wave * 8 + half * 4 + kk) * 32 + 8 * lq;
                        Bf[kk] = *(const bf16x8_t*)(WLR + (size_t)l15 * D_ + ko);
#pragma unroll
                        for (int mt = 0; mt < 2; ++mt) Af[kk][mt] = *(const bf16x8_t*)(XN + (row0 + mt * 16 + l15) * D_ + ko); }
                    asm volatile("" ::: "memory");
#pragma unroll
                    for (int kk = 0; kk < 4; ++kk)
#pragma unroll
                        for (int mt = 0; mt < 2; ++mt) la[mt] = __builtin_amdgcn_mfma_f32_16x16x32_bf16(Af[kk][mt], Bf[kk], la[mt], 0, 0, 0); }
#pragma unroll
                for (int mt = 0; mt < 2; ++mt)
#pragma unroll
                    for (int r = 0; r < 4; ++r) lrp[wave * 512 + (mt * 16 + lq * 4 + r) * 16 + l15] = la[mt][r];
                if (tid < 32) { const f32x4* sp = (const f32x4*)(SS + (row0 + tid) * 32); float t = 0.f;
#pragma unroll
                    for (int j = 0; j < 8; ++j) { const f32x4 v = sp[j]; t += (v[0] + v[1]) + (v[2] + v[3]); }
                    rsl[tid] = rsqrtf(t * (1.0f / D_) + EPS); }
                __syncthreads();
                { float t = 0.f;
#pragma unroll
                  for (int w = 0; w < 8; ++w) t += lrp[w * 512 + tid];
                  LR[row0 * 16 + tid] = t * rsl[tid >> 4]; }
                __syncthreads(); }
            xcd_barrier(bar);
        }
        if (!ANCHOR_GLA) { for (int task = blockIdx.x; task < 512; task += G) gla_a(task, U, LR, w2, b2, LA, DEC, UPDT, lds, tid); }
        if (ANCHOR_GLA) for (int idx = blockIdx.x * NTHR + tid; idx < M_ * 512; idx += G * NTHR) {
            const int row = idx >> 9, c = idx & 511; const float* lr = LR + (size_t)row * 16; float acc = b2[c];
#pragma unroll
            for (int j = 0; j < 16; ++j) acc += lr[j] * w2[j * 512 + c];
            const float ls = fminf(acc, 0.f) - log1pf(__expf(-fabsf(acc)));
            LA[idx] = ls * (1.0f / 16.0f);
        }
        const float* gq = a.in[11]; const float* gk = a.in[12];
        const int e8 = (lane & 15) * 8, sub = lane >> 4;
        f32x4 gq0 = *(const f32x4*)(gq + e8), gq1 = *(const f32x4*)(gq + e8 + 4), gk0 = *(const f32x4*)(gk + e8), gk1 = *(const f32x4*)(gk + e8 + 4);
        v4u qv[4][2];
#pragma unroll
        for (int rr = 0; rr < 4; ++rr)
#pragma unroll
            for (int j = 0; j < 2; ++j) qv[rr][j] = *(const v4u*)(U + (size_t)(gw + rr * NGW) * NINP + MQ_OFF + (sub + 4 * j) * 128 + e8);
        asm volatile("" ::: "memory");
#pragma unroll
        for (int rr = 0; rr < 4; ++rr) { const int row = gw + rr * NGW;
#pragma unroll
            for (int j = 0; j < 2; ++j) { const int hh = sub + 4 * j; bf16* p = U + (size_t)row * NINP + MQ_OFF + hh * 128 + e8;
                const v4u r = qv[rr][j]; float f[8] = {bflo(r.x), bfhi(r.x), bflo(r.y), bfhi(r.y), bflo(r.z), bfhi(r.z), bflo(r.w), bfhi(r.w)};
                float ss = 0.f;
#pragma unroll
                for (int i = 0; i < 8; ++i) ss += f[i] * f[i];
                ss += __shfl_xor(ss, 1); ss += __shfl_xor(ss, 2); ss += __shfl_xor(ss, 4); ss += __shfl_xor(ss, 8);
                const float rs = rsqrtf(ss * (1.0f / 128.0f) + EPS);
                v4u o; o.x = pk2(f[0] * rs * gq0[0], f[1] * rs * gq0[1]); o.y = pk2(f[2] * rs * gq0[2], f[3] * rs * gq0[3]); o.z = pk2(f[4] * rs * gq1[0], f[5] * rs * gq1[1]); o.w = pk2(f[6] * rs * gq1[2], f[7] * rs * gq1[3]);
                *(v4u*)p = o; }
        }
        for (int task = blockIdx.x; task < B_ * 8 * 16; task += G) {
            const int b = task >> 7, h = (task >> 4) & 7, blk = task & 15; float ms[8] = {0.f, 0.f, 0.f, 0.f, 0.f, 0.f, 0.f, 0.f};
            bf16* p0 = U + (size_t)(b * T_ + blk * 256 + 32 * wave + sub) * NINP + MK_OFF + h * 128 + e8;
            v4u rv[8];
#pragma unroll
            for (int it = 0; it < 8; ++it) rv[it] = *(const v4u*)(p0 + (size_t)(it * 4) * NINP);
            asm volatile("" ::: "memory");
#pragma unroll
            for (int it = 0; it < 8; ++it) { const v4u r = rv[it]; float f[8] = {bflo(r.x), bfhi(r.x), bflo(r.y), bfhi(r.y), bflo(r.z), bfhi(r.z), bflo(r.w), bfhi(r.w)};
                float ss = 0.f;
#pragma unroll
                for (int i = 0; i < 8; ++i) ss += f[i] * f[i];
                ss += __shfl_xor(ss, 1); ss += __shfl_xor(ss, 2); ss += __shfl_xor(ss, 4); ss += __shfl_xor(ss, 8);
                const float rs = rsqrtf(ss * (1.0f / 128.0f) + EPS);
                f[0] *= rs * gk0[0]; f[1] *= rs * gk0[1]; f[2] *= rs * gk0[2]; f[3] *= rs * gk0[3]; f[4] *= rs * gk1[0]; f[5] *= rs * gk1[1]; f[6] *= rs * gk1[2]; f[7] *= rs * gk1[3];
#pragma unroll
                for (int i = 0; i < 8; ++i) ms[i] += f[i];
                v4u o; o.x = pk2(f[0], f[1]); o.y = pk2(f[2], f[3]); o.z = pk2(f[4], f[5]); o.w = pk2(f[6], f[7]);
                *(v4u*)(p0 + (size_t)(it * 4) * NINP) = o; }
#pragma unroll
            for (int i = 0; i < 8; ++i) { ms[i] += __shfl_xor(ms[i], 16); ms[i] += __shfl_xor(ms[i], 32); }
            LAS float* part = (LAS float*)lds;
            if (sub == 0) { *(LAS f32x4*)(part + wave * 128 + e8) = (f32x4){ms[0], ms[1], ms[2], ms[3]}; *(LAS f32x4*)(part + wave * 128 + e8 + 4) = (f32x4){ms[4], ms[5], ms[6], ms[7]}; }
            __syncthreads();
            if (tid < 128) { float t = 0.f;
#pragma unroll
                for (int w = 0; w < 8; ++w) t += part[w * 128 + tid];
                KMEAN[(size_t)task * 128 + tid] = t * (1.0f / 256.0f); }
            __syncthreads();
        }
    }
    SEAM(4);
    if (IN(5)) {
        constexpr int NGLA = ANCHOR_GLA ? 16 : 0;
        if (ANCHOR_GLA && (int)blockIdx.x < NGLA) {
            const int bh = blockIdx.x >> 1, b = bh >> 2, h = bh & 3, v = (blockIdx.x & 1) * 128 + (tid >> 2), kp = tid & 3;
            float S[32];
#pragma unroll
            for (int i = 0; i < 32; ++i) S[i] = 0.f;
            for (int t = 0; t < T_; ++t) {
                const size_t row = (size_t)b * T_ + t; const bf16* ur = U + row * NINP;
                const v4u* qp = (const v4u*)(ur + GQ_OFF + h * 128 + kp * 32); const v4u* kpp = (const v4u*)(ur + GK_OFF + h * 128 + kp * 32);
                const f32x4* lap = (const f32x4*)(LA + row * 512 + h * 128 + kp * 32);
                const float vv = bflo((unsigned)ur[GV_OFF + h * 256 + v]);
                float o = 0.f;
#pragma unroll
                for (int i4 = 0; i4 < 4; ++i4) { const v4u qq = qp[i4], kk = kpp[i4]; const f32x4 la0 = lap[2 * i4], la1 = lap[2 * i4 + 1];
                    const float qf[8] = {bflo(qq.x), bfhi(qq.x), bflo(qq.y), bfhi(qq.y), bflo(qq.z), bfhi(qq.z), bflo(qq.w), bfhi(qq.w)};
                    const float kf[8] = {bflo(kk.x), bfhi(kk.x), bflo(kk.y), bfhi(kk.y), bflo(kk.z), bfhi(kk.z), bflo(kk.w), bfhi(kk.w)};
                    const float lf[8] = {la0[0], la0[1], la0[2], la0[3], la1[0], la1[1], la1[2], la1[3]};
#pragma unroll
                    for (int e = 0; e < 8; ++e) { const int i = i4 * 8 + e; S[i] = __expf(lf[e]) * S[i] + kf[e] * vv; o += qf[e] * S[i]; } }
                o *= 0.08838834764831845f;
                o += __shfl_xor(o, 1); o += __shfl_xor(o, 2);
                if (kp == 0) ORAW[row * 1024 + h * 256 + v] = o;
            }
        } else if (!ANCHOR_MOBA) {
            const int p = (int)blockIdx.x - NGLA, pp = p & 127;
            const int bh = pp >> 3, xx = pp & 7, b = bh >> 3, h = bh & 7;
            if (!ANCHOR_GLA && p >= 128 && p < 256) { gla_scan((p - 128) * NTHR + tid, UPDT, DEC, SPT);
                convert_range(IL_W2GU, IL_W2D, (p - 128) * NWAVES + wave, 128 * NWAVES, a, ws, (LAS float*)(lds + wave * 16384), lane); __syncthreads(); }
            if (p < 256) { const bf16* kb = U + (size_t)(b * T_) * NINP + h * 128;
                const int qb = p < 128 ? 15 - xx : xx; const size_t row0 = (size_t)b * T_ + qb * 256;
                att::attn_body<NINP, NINP, D_, 1, 2, (MV_OFF - MK_OFF) * 2, false, true>(U + row0 * NINP + MQ_OFF + h * 128, kb + MK_OFF, MIX + row0 * D_ + 1024 + h * 128, 256 * (qb + 1), (char*)lds_raw,
                                                  nullptr, nullptr, KMEAN + (size_t)(bh * 16) * 128, qb); }
        } else {
            const int nw = (G - NGLA) * NWAVES, w0 = ((int)blockIdx.x - NGLA) * NWAVES + wave;
            LAS float* sc = (LAS float*)(lds + wave * 1024);
            for (int task = w0; task < M_ * 8; task += nw) {
                const int row = task >> 3, h = task & 7, b = row >> 12, t = row & 4095, qblk = t >> 8;
                const unsigned qq = *(const unsigned*)(U + (size_t)row * NINP + MQ_OFF + h * 128 + 2 * lane);
                const float q0 = bflo(qq) * 0.08838834764831845f, q1 = bfhi(qq) * 0.08838834764831845f;
                const float* km = KMEAN + ((size_t)(b * 8 + h) * 16) * 128 + 2 * lane;
                float gt[16];
#pragma unroll
                for (int n = 0; n < 16; ++n) { const f32x2 kv = *(const f32x2*)(km + n * 128); const float d = wave_sum(q0 * kv[0] + q1 * kv[1]); gt[n] = (n < qblk) ? d : -3e38f; }
                unsigned sel = 0;
#pragma unroll
                for (int r = 0; r < 3; ++r) { float best = -3e38f; int bi = -1;
#pragma unroll
                    for (int n = 0; n < 16; ++n) if (gt[n] > best) { best = gt[n]; bi = n; }
                    if (bi >= 0) { sel |= 1u << bi;
#pragma unroll
                        for (int n = 0; n < 16; ++n) if (n == bi) gt[n] = -3e38f; } }
                sel = __builtin_amdgcn_readfirstlane(sel);
                float m = -1e30f, l = 0.f, o0 = 0.f, o1 = 0.f;
                for (int n = 0; n < qblk; ++n) if ((sel >> n) & 1u) { const bf16* kb = U + (size_t)(b * T_ + n * 256) * NINP + h * 128;
                    attn_block<false>(kb + MK_OFF, kb + MV_OFF, NINP, 256, q0, q1, m, l, o0, o1, sc, lane); }
                { const bf16* kb = U + (size_t)(b * T_ + qblk * 256) * NINP + h * 128;
                    attn_block<false>(kb + MK_OFF, kb + MV_OFF, NINP, (t & 255) + 1, q0, q1, m, l, o0, o1, sc, lane); }
                const float il = 1.0f / l;
                *(unsigned*)(MIX + (size_t)row * D_ + 1024 + h * 128 + 2 * lane) = pk2(o0 * il, o1 * il);
            }
        }
    }
    SEAM(5);
    if (IN(6) && !ANCHOR_GLA) { for (int task = blockIdx.x; task < 512; task += G) gla_c(task, U, LA, SPT, a.in[10], MIX, lds, tid); }
    if (IN(6) && ANCHOR_GLA) {
        const float* go = a.in[10]; const f32x4 gv = *(const f32x4*)(go + 4 * lane);
        for (int task = gw; task < M_ * 4; task += NGW) {
            const int row = task >> 2, h = task & 3;
            const f32x4 o = *(const f32x4*)(ORAW + (size_t)row * 1024 + h * 256 + 4 * lane);
            const float ss = wave_sum((o[0] * o[0] + o[1] * o[1]) + (o[2] * o[2] + o[3] * o[3]));
            const float rs = rsqrtf(ss * (1.0f / 256.0f) + EPS);
            const v2u rr = *(const v2u*)(U + (size_t)row * NINP + GR_OFF + h * 256 + 4 * lane);
            const float r0 = bflo(rr.x), r1 = bfhi(rr.x), r2 = bflo(rr.y), r3 = bfhi(rr.y);
            v2u pk; pk.x = pk2(o[0] * rs * gv[0] * pg8::silu_f(r0), o[1] * rs * gv[1] * pg8::silu_f(r1)); pk.y = pk2(o[2] * rs * gv[2] * pg8::silu_f(r2), o[3] * rs * gv[3] * pg8::silu_f(r3));
            *(v2u*)(MIX + (size_t)row * D_ + h * 256 + 4 * lane) = pk;
        }
    }
    SEAM(6);
    if (IN(7)) {
        pg8::Gemm g{MIX, WOUT, M_, D_, D_}; pg8::StaticOrder S; S.init(M_, D_, G, (int)blockIdx.x);
        pg8::EpiRes2<true, false> E{XN, XN, D_, 1.0f, SS};
        pg8::gemm_phase<pg8::EpiRes2<true, false>, pg8::StaticOrder, true, true>(lds, g, S, E);
    }
    SEAM(7);
    if (IN(8)) {
        { pg8::Gemm g{XN, WQ, M_, 512, D_}; pg8::StaticOrder S; S.init(M_, 512, G, (int)blockIdx.x);
          pg8::EpiScale<false> E{XQ, 512, SS, nullptr};
          pg8::gemm_phase<pg8::EpiScale<false>, pg8::StaticOrder, true, true>(lds, g, S, E); }
        { pg8::Gemm g{MEMN, WKV, MM_, 1024, D_}; pg8::StaticOrder S; S.init(MM_, 1024, G, (G - 1) - (int)blockIdx.x);
          pg8::EpiScale<false> E{MKV, 1024, nullptr, nullptr};
          pg8::gemm_phase<pg8::EpiScale<false>, pg8::StaticOrder, true, true>(lds, g, S, E); }
        if ((int)blockIdx.x >= 64 && (int)blockIdx.x < 248) convert_range(IL_W2D, IL_END, ((int)blockIdx.x - 64) * NWAVES + wave, 184 * NWAVES, a, ws, (LAS float*)(lds + wave * 16384), lane);
    }
    SEAM(8);
    if (IN(9) && !ANCHOR_XATTN) {
        for (int task = blockIdx.x; task < 128; task += G) { const int b = task >> 6, h = (task >> 4) & 3, qt = task & 15; const size_t row0 = (size_t)b * T_ + qt * 256;
            const bf16* kb = MKV + (size_t)(b * MEML) * 1024 + h * 128;
            att::attn_body<512, 1024, 512, 0, 2, 1024, true, false>(XQ + row0 * 512 + h * 128, kb, XO + row0 * 512 + h * 128, MEML, (char*)lds_raw, a.in[19], a.in[20], nullptr, 0); }
    }
    if (IN(9) && ANCHOR_XATTN) {
        const float* gq = a.in[19]; const float* gk = a.in[20];
        const float gg0 = gq[2 * lane] * gk[2 * lane] * 0.08838834764831845f, gg1 = gq[2 * lane + 1] * gk[2 * lane + 1] * 0.08838834764831845f;
        LAS float* sc = (LAS float*)(lds + wave * 1024);
        for (int task = gw; task < M_ * 4; task += NGW) {
            const int row = task >> 2, h = task & 3, b = row >> 12;
            const unsigned qq = *(const unsigned*)(XQ + (size_t)row * 512 + h * 128 + 2 * lane);
            float q0 = bflo(qq), q1 = bfhi(qq);
            const float rs = rsqrtf(wave_sum(q0 * q0 + q1 * q1) * (1.0f / 128.0f) + EPS);
            q0 *= rs * gg0; q1 *= rs * gg1;
            float m = -1e30f, l = 0.f, o0 = 0.f, o1 = 0.f;
            const bf16* kb = MKV + (size_t)(b * MEML) * 1024 + h * 128;
            attn_block<true>(kb, kb + 512, 1024, MEML, q0, q1, m, l, o0, o1, sc, lane);
            const float il = 1.0f / l;
            *(unsigned*)(XO + (size_t)row * 512 + h * 128 + 2 * lane) = pk2(o0 * il, o1 * il);
        }
    }
    SEAM(9);
    if (IN(10)) {
        pg8::Gemm g{XO, WO, M_, D_, 512}; pg8::StaticOrder S; S.init(M_, D_, G, (int)blockIdx.x);
        pg8::EpiRes2<true, false> E{XN, XN, D_, 1.0f, SS};
        pg8::gemm_phase<pg8::EpiRes2<true, false>, pg8::StaticOrder, true, true>(lds, g, S, E);
    }
    SEAM(10);
    if (IN(11)) {
        pg8::Gemm g{XN, W2GU, M_, NGU, D_}; pg8::StaticOrder S; S.init(M_, NGU, G, (int)blockIdx.x);
        pg8::EpiSwiGLU E{ACT, FF_, SS};
        pg8::gemm_phase<pg8::EpiSwiGLU, pg8::StaticOrder, true, true>(lds, g, S, E);
    }
    SEAM(11);
    if (IN(12)) {
        pg8::Gemm g{ACT, W2D, M_, D_, FF_}; pg8::StaticOrder S; S.init(M_, D_, G, (int)blockIdx.x);
        pg8::EpiRes2<true, true> E{XN, out, D_, 0.5f, nullptr};
        pg8::gemm_phase<pg8::EpiRes2<true, true>, pg8::StaticOrder, true, true>(lds, g, S, E);
    }
#undef IN
#undef SEAM
#ifdef PROBE_REP
#define IN(k) (a.lo2 <= (k) && (k) < a.hi2)
#define SEAM(k) do { if (a.lo2 <= (k) && (k) + 1 < a.hi2) xcd_barrier(bar); } while (0)

    if (IN(0)) {
        LAS float* scr = (LAS float*)(lds + wave * 16384);
        convert_range(IL_W1GU, IL_W1D, gw, NGW, a, ws, scr, lane);
        if (gw >= 768) convert_range(IL_WOUT, IL_W2GU, gw - 768, NGW - 768, a, ws, scr, lane);
        const float* g1 = a.in[2];
        for (int m = gw; m < M_; m += NGW) {
            const f32x4* xr = (const f32x4*)(x + (size_t)m * D_) + lane; f32x4 v[8]; float ss = 0.f;
#pragma unroll
            for (int j = 0; j < 8; ++j) { v[j] = xr[64 * j]; ss += (v[j][0] * v[j][0] + v[j][1] * v[j][1]) + (v[j][2] * v[j][2] + v[j][3] * v[j][3]); }
            ss = wave_sum(ss);
#pragma unroll
            for (int j = 0; j < 8; ++j) { const f32x4 w = v[j]; v2u pk; pk.x = pk2(w[0], w[1]); pk.y = pk2(w[2], w[3]);
                *(v2u*)(XN + (size_t)m * D_ + 4 * lane + 256 * j) = pk; }
            if (lane < 32) SS[(size_t)m * 32 + lane] = (lane == 0) ? ss : 0.f;
        }
        const float* gm = a.in[15]; const float* mem = a.in[1];
        for (int m = gw; m < MM_; m += NGW) {
            const f32x4* xr = (const f32x4*)(mem + (size_t)m * D_) + lane; f32x4 v[8]; float ss = 0.f;
#pragma unroll
            for (int j = 0; j < 8; ++j) { v[j] = xr[64 * j]; ss += (v[j][0] * v[j][0] + v[j][1] * v[j][1]) + (v[j][2] * v[j][2] + v[j][3] * v[j][3]); }
            const float rs = rsqrtf(wave_sum(ss) * (1.0f / D_) + EPS);
#pragma unroll
            for (int j = 0; j < 8; ++j) { const f32x4 gv = ((const f32x4*)gm)[lane + 64 * j]; const f32x4 w = v[j] * gv * rs; v2u pk; pk.x = pk2(w[0], w[1]); pk.y = pk2(w[2], w[3]);
                *(v2u*)(MEMN + (size_t)m * D_ + 4 * lane + 256 * j) = pk; }
        }
        __syncthreads();
    }
    SEAM(0);
#ifdef PROBE_SYNCS
    for (int i_ = 0; i_ < PROBE_SYNCS; ++i_) xcd_barrier(bar);
#endif
    if (IN(1)) {
        pg8::Gemm g{XN, W1GU, M_, NGU, D_}; pg8::StaticOrder S; S.init(M_, NGU, G, (int)blockIdx.x);
        pg8::EpiSwiGLU E{ACT, FF_, SS};
        pg8::gemm_phase<pg8::EpiSwiGLU, pg8::StaticOrder, true, true>(lds, g, S, E);
        if ((int)blockIdx.x >= 128) convert_range(IL_W1D, IL_WOUT, ((int)blockIdx.x - 128) * NWAVES + wave, (G - 128) * NWAVES, a, ws, (LAS float*)(lds + wave * 16384), lane);
    }
    SEAM(1);
    if (IN(2)) {
        pg8::Gemm g{ACT, W1D, M_, D_, FF_}; pg8::StaticOrder S; S.init(M_, D_, G, (int)blockIdx.x);
        pg8::EpiRes2<false, false> E{x, XN, D_, 0.5f, SS};
        pg8::gemm_phase<pg8::EpiRes2<false, false>, pg8::StaticOrder, true, true>(lds, g, S, E);
    }
    SEAM(2);
    if (IN(3)) {
        pg8::Gemm g{XN, WIN, M_, NU, D_}; pg8::StaticOrder S; S.init(M_, NU, G, (int)blockIdx.x);
        pg8::EpiScale<false> E{U, NINP, SS, nullptr};
        pg8::gemm_phase<pg8::EpiScale<false>, pg8::StaticOrder, true, true>(lds, g, S, E);
    }
    SEAM(3);
    if (IN(4)) {
        const float* w2 = a.in[8]; const float* b2 = a.in[9];
        {
            const bf16* WLR = WIN + (size_t)NU * D_; const int l15 = lane & 15, lq = lane >> 4;
            LAS float* lrp = (LAS float*)lds;
            LAS float* rsl = (LAS float*)(lds + 16384);
            for (int rb = blockIdx.x; rb < M_ / 32; rb += G) { const size_t row0 = (size_t)rb * 32;
                f32x4 la[2] = {(f32x4){0.f, 0.f, 0.f, 0.f}, (f32x4){0.f, 0.f, 0.f, 0.f}};
#pragma unroll
                for (int half = 0; half < 2; ++half) { bf16x8_t Bf[4], Af[4][2];
#pragma unroll
                    for (int kk = 0; kk < 4; ++kk) { const int ko = (wave * 8 + half * 4 + kk) * 32 + 8 * lq;
                        Bf[kk] = *(const bf16x8_t*)(WLR + (size_t)l15 * D_ + ko);
#pragma unroll
                        for (int mt = 0; mt < 2; ++mt) Af[kk][mt] = *(const bf16x8_t*)(XN + (row0 + mt * 16 + l15) * D_ + ko); }
                    asm volatile("" ::: "memory");
#pragma unroll
                    for (int kk = 0; kk < 4; ++kk)
#pragma unroll
                        for (int mt = 0; mt < 2; ++mt) la[mt] = __builtin_amdgcn_mfma_f32_16x16x32_bf16(Af[kk][mt], Bf[kk], la[mt], 0, 0, 0); }
#pragma unroll
                for (int mt = 0; mt < 2; ++mt)
#pragma unroll
                    for (int r = 0; r < 4; ++r) lrp[wave * 512 + (mt * 16 + lq * 4 + r) * 16 + l15] = la[mt][r];
                if (tid < 32) { const f32x4* sp = (const f32x4*)(SS + (row0 + tid) * 32); float t = 0.f;
#pragma unroll
                    for (int j = 0; j < 8; ++j) { const f32x4 v = sp[j]; t += (v[0] + v[1]) + (v[2] + v[3]); }
                    rsl[tid] = rsqrtf(t * (1.0f / D_) + EPS); }
                __syncthreads();
                { float t = 0.f;
#pragma unroll
                  for (int w = 0; w < 8; ++w) t += lrp[w * 512 + tid];
                  LR[row0 * 16 + tid] = t * rsl[tid >> 4]; }
                __syncthreads(); }
            xcd_barrier(bar);
        }
        if (!ANCHOR_GLA) { for (int task = blockIdx.x; task < 512; task += G) gla_a(task, U, LR, w2, b2, LA, DEC, UPDT, lds, tid); }
        if (ANCHOR_GLA) for (int idx = blockIdx.x * NTHR + tid; idx < M_ * 512; idx += G * NTHR) {
            const int row = idx >> 9, c = idx & 511; const float* lr = LR + (size_t)row * 16; float acc = b2[c];
#pragma unroll
            for (int j = 0; j < 16; ++j) acc += lr[j] * w2[j * 512 + c];
            const float ls = fminf(acc, 0.f) - log1pf(__expf(-fabsf(acc)));
            LA[idx] = ls * (1.0f / 16.0f);
        }
        const float* gq = a.in[11]; const float* gk = a.in[12];
        const int e8 = (lane & 15) * 8, sub = lane >> 4;
        f32x4 gq0 = *(const f32x4*)(gq + e8), gq1 = *(const f32x4*)(gq + e8 + 4), gk0 = *(const f32x4*)(gk + e8), gk1 = *(const f32x4*)(gk + e8 + 4);
        v4u qv[4][2];
#pragma unroll
        for (int rr = 0; rr < 4; ++rr)
#pragma unroll
            for (int j = 0; j < 2; ++j) qv[rr][j] = *(const v4u*)(U + (size_t)(gw + rr * NGW) * NINP + MQ_OFF + (sub + 4 * j) * 128 + e8);
        asm volatile("" ::: "memory");
#pragma unroll
        for (int rr = 0; rr < 4; ++rr) { const int row = gw + rr * NGW;
#pragma unroll
            for (int j = 0; j < 2; ++j) { const int hh = sub + 4 * j; bf16* p = U + (size_t)row * NINP + MQ_OFF + hh * 128 + e8;
                const v4u r = qv[rr][j]; float f[8] = {bflo(r.x), bfhi(r.x), bflo(r.y), bfhi(r.y), bflo(r.z), bfhi(r.z), bflo(r.w), bfhi(r.w)};
                float ss = 0.f;
#pragma unroll
                for (int i = 0; i < 8; ++i) ss += f[i] * f[i];
                ss += __shfl_xor(ss, 1); ss += __shfl_xor(ss, 2); ss += __shfl_xor(ss, 4); ss += __shfl_xor(ss, 8);
                const float rs = rsqrtf(ss * (1.0f / 128.0f) + EPS);
                v4u o; o.x = pk2(f[0] * rs * gq0[0], f[1] * rs * gq0[1]); o.y = pk2(f[2] * rs * gq0[2], f[3] * rs * gq0[3]); o.z = pk2(f[4] * rs * gq1[0], f[5] * rs * gq1[1]); o.w = pk2(f[6] * rs * gq1[2], f[7] * rs * gq1[3]);
                *(v4u*)p = o; }
        }
        for (int task = blockIdx.x; task < B_ * 8 * 16; task += G) {
            const int b = task >> 7, h = (task >> 4) & 7, blk = task & 15; float ms[8] = {0.f, 0.f, 0.f, 0.f, 0.f, 0.f, 0.f, 0.f};
            bf16* p0 = U + (size_t)(b * T_ + blk * 256 + 32 * wave + sub) * NINP + MK_OFF + h * 128 + e8;
            v4u rv[8];
#pragma unroll
            for (int it = 0; it < 8; ++it) rv[it] = *(const v4u*)(p0 + (size_t)(it * 4) * NINP);
            asm volatile("" ::: "memory");
#pragma unroll
            for (int it = 0; it < 8; ++it) { const v4u r = rv[it]; float f[8] = {bflo(r.x), bfhi(r.x), bflo(r.y), bfhi(r.y), bflo(r.z), bfhi(r.z), bflo(r.w), bfhi(r.w)};
                float ss = 0.f;
#pragma unroll
                for (int i = 0; i < 8; ++i) ss += f[i] * f[i];
                ss += __shfl_xor(ss, 1); ss += __shfl_xor(ss, 2); ss += __shfl_xor(ss, 4); ss += __shfl_xor(ss, 8);
                const float rs = rsqrtf(ss * (1.0f / 128.0f) + EPS);
                f[0] *= rs * gk0[0]; f[1] *= rs * gk0[1]; f[2] *= rs * gk0[2]; f[3] *= rs * gk0[3]; f[4] *= rs * gk1[0]; f[5] *= rs * gk1[1]; f[6] *= rs * gk1[2]; f[7] *= rs * gk1[3];
#pragma unroll
                for (int i = 0; i < 8; ++i) ms[i] += f[i];
                v4u o; o.x = pk2(f[0], f[1]); o.y = pk2(f[2], f[3]); o.z = pk2(f[4], f[5]); o.w = pk2(f[6], f[7]);
                *(v4u*)(p0 + (size_t)(it * 4) * NINP) = o; }
#pragma unroll
            for (int i = 0; i < 8; ++i) { ms[i] += __shfl_xor(ms[i], 16); ms[i] += __shfl_xor(ms[i], 32); }
            LAS float* part = (LAS float*)lds;
            if (sub == 0) { *(LAS f32x4*)(part + wave * 128 + e8) = (f32x4){ms[0], ms[1], ms[2], ms[3]}; *(LAS f32x4*)(part + wave * 128 + e8 + 4) = (f32x4){ms[4], ms[5], ms[6], ms[7]}; }
            __syncthreads();
            if (tid < 128) { float t = 0.f;
#pragma unroll
                for (int w = 0; w < 8; ++w) t += part[w * 128 + tid];
                KMEAN[(size_t)task * 128 + tid] = t * (1.0f / 256.0f); }
            __syncthreads();
        }
    }
    SEAM(4);
    if (IN(5)) {
        constexpr int NGLA = ANCHOR_GLA ? 16 : 0;
        if (ANCHOR_GLA && (int)blockIdx.x < NGLA) {
            const int bh = blockIdx.x >> 1, b = bh >> 2, h = bh & 3, v = (blockIdx.x & 1) * 128 + (tid >> 2), kp = tid & 3;
            float S[32];
#pragma unroll
            for (int i = 0; i < 32; ++i) S[i] = 0.f;
            for (int t = 0; t < T_; ++t) {
                const size_t row = (size_t)b * T_ + t; const bf16* ur = U + row * NINP;
                const v4u* qp = (const v4u*)(ur + GQ_OFF + h * 128 + kp * 32); const v4u* kpp = (const v4u*)(ur + GK_OFF + h * 128 + kp * 32);
                const f32x4* lap = (const f32x4*)(LA + row * 512 + h * 128 + kp * 32);
                const float vv = bflo((unsigned)ur[GV_OFF + h * 256 + v]);
                float o = 0.f;
#pragma unroll
                for (int i4 = 0; i4 < 4; ++i4) { const v4u qq = qp[i4], kk = kpp[i4]; const f32x4 la0 = lap[2 * i4], la1 = lap[2 * i4 + 1];
                    const float qf[8] = {bflo(qq.x), bfhi(qq.x), bflo(qq.y), bfhi(qq.y), bflo(qq.z), bfhi(qq.z), bflo(qq.w), bfhi(qq.w)};
                    const float kf[8] = {bflo(kk.x), bfhi(kk.x), bflo(kk.y), bfhi(kk.y), bflo(kk.z), bfhi(kk.z), bflo(kk.w), bfhi(kk.w)};
                    const float lf[8] = {la0[0], la0[1], la0[2], la0[3], la1[0], la1[1], la1[2], la1[3]};
#pragma unroll
                    for (int e = 0; e < 8; ++e) { const int i = i4 * 8 + e; S[i] = __expf(lf[e]) * S[i] + kf[e] * vv; o += qf[e] * S[i]; } }
                o *= 0.08838834764831845f;
                o += __shfl_xor(o, 1); o += __shfl_xor(o, 2);
                if (kp == 0) ORAW[row * 1024 + h * 256 + v] = o;
            }
        } else if (!ANCHOR_MOBA) {
            const int p = (int)blockIdx.x - NGLA, pp = p & 127;
            const int bh = pp >> 3, xx = pp & 7, b = bh >> 3, h = bh & 7;
            if (!ANCHOR_GLA && p >= 128 && p < 256) { gla_scan((p - 128) * NTHR + tid, UPDT, DEC, SPT);
                convert_range(IL_W2GU, IL_W2D, (p - 128) * NWAVES + wave, 128 * NWAVES, a, ws, (LAS float*)(lds + wave * 16384), lane); __syncthreads(); }
            if (p < 256) { const bf16* kb = U + (size_t)(b * T_) * NINP + h * 128;
                const int qb = p < 128 ? 15 - xx : xx; const size_t row0 = (size_t)b * T_ + qb * 256;
                att::attn_body<NINP, NINP, D_, 1, 2, (MV_OFF - MK_OFF) * 2, false, true>(U + row0 * NINP + MQ_OFF + h * 128, kb + MK_OFF, MIX + row0 * D_ + 1024 + h * 128, 256 * (qb + 1), (char*)lds_raw,
                                                  nullptr, nullptr, KMEAN + (size_t)(bh * 16) * 128, qb); }
        } else {
            const int nw = (G - NGLA) * NWAVES, w0 = ((int)blockIdx.x - NGLA) * NWAVES + wave;
            LAS float* sc = (LAS float*)(lds + wave * 1024);
            for (int task = w0; task < M_ * 8; task += nw) {
                const int row = task >> 3, h = task & 7, b = row >> 12, t = row & 4095, qblk = t >> 8;
                const unsigned qq = *(const unsigned*)(U + (size_t)row * NINP + MQ_OFF + h * 128 + 2 * lane);
                const float q0 = bflo(qq) * 0.08838834764831845f, q1 = bfhi(qq) * 0.08838834764831845f;
                const float* km = KMEAN + ((size_t)(b * 8 + h) * 16) * 128 + 2 * lane;
                float gt[16];
#pragma unroll
                for (int n = 0; n < 16; ++n) { const f32x2 kv = *(const f32x2*)(km + n * 128); const float d = wave_sum(q0 * kv[0] + q1 * kv[1]); gt[n] = (n < qblk) ? d : -3e38f; }
                unsigned sel = 0;
#pragma unroll
                for (int r = 0; r < 3; ++r) { float best = -3e38f; int bi = -1;
#pragma unroll
                    for (int n = 0; n < 16; ++n) if (gt[n] > best) { best = gt[n]; bi = n; }
                    if (bi >= 0) { sel |= 1u << bi;
#pragma unroll
                        for (int n = 0; n < 16; ++n) if (n == bi) gt[n] = -3e38f; } }
                sel = __builtin_amdgcn_readfirstlane(sel);
                float m = -1e30f, l = 0.f, o0 = 0.f, o1 = 0.f;
                for (int n = 0; n < qblk; ++n) if ((sel >> n) & 1u) { const bf16* kb = U + (size_t)(b * T_ + n * 256) * NINP + h * 128;
                    attn_block<false>(kb + MK_OFF, kb + MV_OFF, NINP, 256, q0, q1, m, l, o0, o1, sc, lane); }
                { const bf16* kb = U + (size_t)(b * T_ + qblk * 256) * NINP + h * 128;
                    attn_block<false>(kb + MK_OFF, kb + MV_OFF, NINP, (t & 255) + 1, q0, q1, m, l, o0, o1, sc, lane); }
                const float il = 1.0f / l;
                *(unsigned*)(MIX + (size_t)row * D_ + 1024 + h * 128 + 2 * lane) = pk2(o0 * il, o1 * il);
            }
        }
    }
    SEAM(5);
    if (IN(6) && !ANCHOR_GLA) { for (int task = blockIdx.x; task < 512; task += G) gla_c(task, U, LA, SPT, a.in[10], MIX, lds, tid); }
    if (IN(6) && ANCHOR_GLA) {
        const float* go = a.in[10]; const f32x4 gv = *(const f32x4*)(go + 4 * lane);
        for (int task = gw; task < M_ * 4; task += NGW) {
            const int row = task >> 2, h = task & 3;
            const f32x4 o = *(const f32x4*)(ORAW + (size_t)row * 1024 + h * 256 + 4 * lane);
            const float ss = wave_sum((o[0] * o[0] + o[1] * o[1]) + (o[2] * o[2] + o[3] * o[3]));
            const float rs = rsqrtf(ss * (1.0f / 256.0f) + EPS);
            const v2u rr = *(const v2u*)(U + (size_t)row * NINP + GR_OFF + h * 256 + 4 * lane);
            const float r0 = bflo(rr.x), r1 = bfhi(rr.x), r2 = bflo(rr.y), r3 = bfhi(rr.y);
            v2u pk; pk.x = pk2(o[0] * rs * gv[0] * pg8::silu_f(r0), o[1] * rs * gv[1] * pg8::silu_f(r1)); pk.y = pk2(o[2] * rs * gv[2] * pg8::silu_f(r2), o[3] * rs * gv[3] * pg8::silu_f(r3));
            *(v2u*)(MIX + (size_t)row * D_ + h * 256 + 4 * lane) = pk;
        }
    }
    SEAM(6);
    if (IN(7)) {
        pg8::Gemm g{MIX, WOUT, M_, D_, D_}; pg8::StaticOrder S; S.init(M_, D_, G, (int)blockIdx.x);
        pg8::EpiRes2<true, false> E{XN, XN, D_, 1.0f, SS};
        pg8::gemm_phase<pg8::EpiRes2<true, false>, pg8::StaticOrder, true, true>(lds, g, S, E);
    }
    SEAM(7);
    if (IN(8)) {
        { pg8::Gemm g{XN, WQ, M_, 512, D_}; pg8::StaticOrder S; S.init(M_, 512, G, (int)blockIdx.x);
          pg8::EpiScale<false> E{XQ, 512, SS, nullptr};
          pg8::gemm_phase<pg8::EpiScale<false>, pg8::StaticOrder, true, true>(lds, g, S, E); }
        { pg8::Gemm g{MEMN, WKV, MM_, 1024, D_}; pg8::StaticOrder S; S.init(MM_, 1024, G, (G - 1) - (int)blockIdx.x);
          pg8::EpiScale<false> E{MKV, 1024, nullptr, nullptr};
          pg8::gemm_phase<pg8::EpiScale<false>, pg8::StaticOrder, true, true>(lds, g, S, E); }
        if ((int)blockIdx.x >= 64 && (int)blockIdx.x < 248) convert_range(IL_W2D, IL_END, ((int)blockIdx.x - 64) * NWAVES + wave, 184 * NWAVES, a, ws, (LAS float*)(lds + wave * 16384), lane);
    }
    SEAM(8);
    if (IN(9) && !ANCHOR_XATTN) {
        for (int task = blockIdx.x; task < 128; task += G) { const int b = task >> 6, h = (task >> 4) & 3, qt = task & 15; const size_t row0 = (size_t)b * T_ + qt * 256;
            const bf16* kb = MKV + (size_t)(b * MEML) * 1024 + h * 128;
            att::attn_body<512, 1024, 512, 0, 2, 1024, true, false>(XQ + row0 * 512 + h * 128, kb, XO + row0 * 512 + h * 128, MEML, (char*)lds_raw, a.in[19], a.in[20], nullptr, 0); }
    }
    if (IN(9) && ANCHOR_XATTN) {
        const float* gq = a.in[19]; const float* gk = a.in[20];
        const float gg0 = gq[2 * lane] * gk[2 * lane] * 0.08838834764831845f, gg1 = gq[2 * lane + 1] * gk[2 * lane + 1] * 0.08838834764831845f;
        LAS float* sc = (LAS float*)(lds + wave * 1024);
        for (int task = gw; task < M_ * 4; task += NGW) {
            const int row = task >> 2, h = task & 3, b = row >> 12;
            const unsigned qq = *(const unsigned*)(XQ + (size_t)row * 512 + h * 128 + 2 * lane);
            float q0 = bflo(qq), q1 = bfhi(qq);
            const float rs = rsqrtf(wave_sum(q0 * q0 + q1 * q1) * (1.0f / 128.0f) + EPS);
            q0 *= rs * gg0; q1 *= rs * gg1;
            float m = -1e30f, l = 0.f, o0 = 0.f, o1 = 0.f;
            const bf16* kb = MKV + (size_t)(b * MEML) * 1024 + h * 128;
            attn_block<true>(kb, kb + 512, 1024, MEML, q0, q1, m, l, o0, o1, sc, lane);
            const float il = 1.0f / l;
            *(unsigned*)(XO + (size_t)row * 512 + h * 128 + 2 * lane) = pk2(o0 * il, o1 * il);
        }
    }
    SEAM(9);
    if (IN(10)) {
        pg8::Gemm g{XO, WO, M_, D_, 512}; pg8::StaticOrder S; S.init(M_, D_, G, (int)blockIdx.x);
        pg8::EpiRes2<true, false> E{XN, XN, D_, 1.0f, SS};
        pg8::gemm_phase<pg8::EpiRes2<true, false>, pg8::StaticOrder, true, true>(lds, g, S, E);
    }
    SEAM(10);
    if (IN(11)) {
        pg8::Gemm g{XN, W2GU, M_, NGU, D_}; pg8::StaticOrder S; S.init(M_, NGU, G, (int)blockIdx.x);
        pg8::EpiSwiGLU E{ACT, FF_, SS};
        pg8::gemm_phase<pg8::EpiSwiGLU, pg8::StaticOrder, true, true>(lds, g, S, E);
    }
    SEAM(11);
    if (IN(12)) {
        pg8::Gemm g{ACT, W2D, M_, D_, FF_}; pg8::StaticOrder S; S.init(M_, D_, G, (int)blockIdx.x);
        pg8::EpiRes2<true, true> E{XN, out, D_, 0.5f, nullptr};
        pg8::gemm_phase<pg8::EpiRes2<true, true>, pg8::StaticOrder, true, true>(lds, g, S, E);
    }
#undef IN
#undef SEAM
#endif
}

extern "C" void kernel_launch(void* const* d_in, const int* in_sizes, int n_in, void* d_out, int out_size, void* d_ws, size_t ws_size, hipStream_t stream) {
    static int grid = 0;
    if (grid == 0) {
        if (n_in != 25 || in_sizes[0] != M_ * D_ || out_size != M_ * D_ || ws_size < WS_END) { fprintf(stderr, "kernel_launch: unexpected shapes (n_in %d, in0 %d, out %d, ws %zu < %zu); nothing launched\n", n_in, n_in > 0 ? in_sizes[0] : -1, out_size, ws_size, (size_t)WS_END); grid = -1; return; }
        int dev = 0, cus = 0, per_cu = 0;
        if (hipGetDevice(&dev) != hipSuccess || hipDeviceGetAttribute(&cus, hipDeviceAttributeMultiprocessorCount, dev) != hipSuccess) { fprintf(stderr, "kernel_launch: device query failed\n"); grid = -1; return; }
        if (hipFuncSetAttribute((const void*)hymba_fwd, hipFuncAttributeMaxDynamicSharedMemorySize, LDS_BYTES) != hipSuccess) { fprintf(stderr, "kernel_launch: hipFuncSetAttribute failed\n"); grid = -1; return; }
        if (hipOccupancyMaxActiveBlocksPerMultiprocessor(&per_cu, (const void*)hymba_fwd, NTHR, LDS_BYTES) != hipSuccess || per_cu < 1) { fprintf(stderr, "kernel_launch: occupancy query says %d blocks per CU\n", per_cu); per_cu = 1; }
        (void)hipGetLastError();
        grid = cus * 1;
        fprintf(stderr, "kernel_launch: grid %d (cus %d, per_cu %d)\n", grid, cus, per_cu);
    }
    if (grid < 0) return;
    Args a{};
    for (int i = 0; i < 25; ++i) a.in[i] = (const float*)d_in[i];
    a.out = (float*)d_out; a.ws = (unsigned char*)d_ws;
#ifdef PROBE_REP
    a.lo1 = 0; a.hi1 = PROBE_REP + 1; a.lo2 = PROBE_REP; a.hi2 = NPH;
#else
    a.lo1 = 0; a.hi1 = NPH; a.lo2 = 0; a.hi2 = 0;
#endif
    if (hipMemsetAsync(d_ws, 0, 16384, stream) != hipSuccess) { fprintf(stderr, "kernel_launch: hipMemsetAsync failed\n"); return; }
    void* args[] = {&a};
    const hipError_t e = hipLaunchCooperativeKernel((const void*)hymba_fwd, dim3(grid), dim3(NTHR), args, LDS_BYTES, stream);
    if (e != hipSuccess) fprintf(stderr, "kernel_launch: cooperative launch failed: %s (grid %d)\n", hipGetErrorString(e), grid);
}
```
